# Optimizing an MI355X kernel written in HIP

```python
import math
import jax, jax.numpy as jnp
from jax import lax
import numpy as np

D_MODEL = 2048
BATCH = 2
SEQ = 8192
DEPTH = 1

N_META = 16
HEAD_DIM = 128
A_HEADS = 8
IDX_HEADS = 16
IDX_DIM = 64
TOPK_MAX = 256
B_HEADS = 4
N_EXPERTS = 32
TOP_K = 4
D_FF = 2048
SWIGLU_LIMIT = 7.0
SWIGLU_ALPHA = 1.702

ROPE_THETA = 10000.0
RMS_EPS = 1e-5
Q_BLOCK = 128
MOE_BLOCK = 128

A_WIDTH = A_HEADS * HEAD_DIM
B_QK_WIDTH = B_HEADS * 2 * HEAD_DIM
B_V_WIDTH = B_HEADS * 2 * HEAD_DIM
SPLIT_SIZES = (A_WIDTH, A_WIDTH, A_WIDTH,
               IDX_HEADS * IDX_DIM, IDX_DIM, IDX_HEADS,
               B_QK_WIDTH, B_QK_WIDTH, B_V_WIDTH,
               D_MODEL, D_MODEL)
D_IN = 3 * A_WIDTH + IDX_HEADS * IDX_DIM + IDX_DIM + IDX_HEADS + 2 * B_QK_WIDTH + B_V_WIDTH + 2 * D_MODEL

kernel_name = 'hybrid_dsa_diffattn_moe_block'


def rmsnorm(x, g):
    xf = x.astype(jnp.float32)
    y = xf * lax.rsqrt(jnp.mean(xf * xf, axis=-1, keepdims=True) + RMS_EPS)
    return (y * g.astype(jnp.float32)).astype(x.dtype)


def rope_tables(n_pos, dim):
    inv = 1.0 / (ROPE_THETA ** (jnp.arange(0, dim, 2, dtype=jnp.float32) / dim))
    ang = jnp.arange(n_pos, dtype=jnp.float32)[:, None] * inv[None, :]
    ang = jnp.concatenate([ang, ang], axis=-1)
    return jnp.cos(ang), jnp.sin(ang)


def apply_rope(x, cos, sin):
    xf = x.astype(jnp.float32)
    half = xf.shape[-1] // 2
    rot = jnp.concatenate([-xf[..., half:], xf[..., :half]], axis=-1)
    return (xf * cos[None, :, None, :] + rot * sin[None, :, None, :]).astype(x.dtype)


def _split_columns(proj):
    outs = []
    off = 0
    for size in SPLIT_SIZES:
        outs.append(proj[..., off:off + size])
        off += size
    return outs


def dsa_attention(q, k, v, q_idx, k_idx, w_idx, topk):
    bsz, tp, n_h, d = q.shape
    nb = tp // Q_BLOCK
    key_pos = jnp.arange(tp)
    scale = HEAD_DIM ** -0.5
    w_scaled = w_idx * (IDX_HEADS ** -0.5 * IDX_DIM ** -0.5)

    def block(i):
        start = i * Q_BLOCK
        qi = lax.dynamic_slice_in_dim(q_idx, start, Q_BLOCK, axis=1)
        wi = lax.dynamic_slice_in_dim(w_scaled, start, Q_BLOCK, axis=1)
        qa = lax.dynamic_slice_in_dim(q, start, Q_BLOCK, axis=1)
        q_pos = start + jnp.arange(Q_BLOCK)
        causal = key_pos[None, :] <= q_pos[:, None]
        rel = jax.nn.relu(jnp.einsum('bqhd,bkd->bqhk', qi, k_idx))
        score = jnp.einsum('bqhk,bqh->bqk', rel, wi).astype(jnp.float32)
        score = jnp.where(causal[None], score, -jnp.inf)
        _, sel = lax.top_k(score, topk)
        valid = sel <= q_pos[None, :, None]
        k_sel = jax.vmap(lambda kk, ii: kk[ii])(k, sel)
        v_sel = jax.vmap(lambda vv, ii: vv[ii])(v, sel)
        s = jnp.einsum('bqhd,bqkhd->bhqk', qa, k_sel).astype(jnp.float32) * scale
        s = jnp.where(valid[:, None], s, -jnp.inf)
        p = jax.nn.softmax(s, axis=-1).astype(v.dtype)
        return jnp.einsum('bhqk,bqkhd->bqhd', p, v_sel)

    out = lax.map(block, jnp.arange(nb))
    return jnp.moveaxis(out, 0, 1).reshape(bsz, tp, n_h, d)


def diff_attention(q1, q2, k1, k2, v, lam):
    bsz, tp, n_h, dv = v.shape
    nb = tp // Q_BLOCK
    key_pos = jnp.arange(tp)
    scale = HEAD_DIM ** -0.5

    def block(i):
        start = i * Q_BLOCK
        q1b = lax.dynamic_slice_in_dim(q1, start, Q_BLOCK, axis=1)
        q2b = lax.dynamic_slice_in_dim(q2, start, Q_BLOCK, axis=1)
        q_pos = start + jnp.arange(Q_BLOCK)
        causal = (key_pos[None, :] <= q_pos[:, None])[None, None]
        s1 = jnp.einsum('bqhd,bkhd->bhqk', q1b, k1).astype(jnp.float32) * scale
        s2 = jnp.einsum('bqhd,bkhd->bhqk', q2b, k2).astype(jnp.float32) * scale
        p1 = jax.nn.softmax(jnp.where(causal, s1, -jnp.inf), axis=-1)
        p2 = jax.nn.softmax(jnp.where(causal, s2, -jnp.inf), axis=-1)
        a = (p1 - lam * p2).astype(v.dtype)
        return jnp.einsum('bhqk,bkhe->bqhe', a, v)

    out = lax.map(block, jnp.arange(nb))
    return jnp.moveaxis(out, 0, 1).reshape(bsz, tp, n_h, dv)


def hybrid_mixer(h, w_in, lambda_q1, lambda_k1, lambda_q2, lambda_k2, subln_g, w_up_a, w_up_b, w_out,
                 cos, sin, cos_i, sin_i, topk, lambda_init):
    bsz, tp, _ = h.shape
    proj = h @ w_in
    qa, ka, va, qi, ki, wi, qb, kb, vb, ga, gb = _split_columns(proj)

    qa = apply_rope(qa.reshape(bsz, tp, A_HEADS, HEAD_DIM), cos, sin)
    ka = apply_rope(ka.reshape(bsz, tp, A_HEADS, HEAD_DIM), cos, sin)
    va = va.reshape(bsz, tp, A_HEADS, HEAD_DIM)
    qi = apply_rope(qi.reshape(bsz, tp, IDX_HEADS, IDX_DIM), cos_i, sin_i)
    ki = apply_rope(ki[:, :, None, :], cos_i, sin_i)[:, :, 0, :]
    o_a = dsa_attention(qa, ka, va, qi, ki, wi, topk).reshape(bsz, tp, A_WIDTH)

    qb = qb.reshape(bsz, tp, B_HEADS, 2, HEAD_DIM)
    kb = kb.reshape(bsz, tp, B_HEADS, 2, HEAD_DIM)
    q1 = apply_rope(qb[..., 0, :], cos, sin)
    q2 = apply_rope(qb[..., 1, :], cos, sin)
    k1 = apply_rope(kb[..., 0, :], cos, sin)
    k2 = apply_rope(kb[..., 1, :], cos, sin)
    vb = vb.reshape(bsz, tp, B_HEADS, 2 * HEAD_DIM)
    lam = (jnp.exp(jnp.sum(lambda_q1.astype(jnp.float32) * lambda_k1.astype(jnp.float32)))
           - jnp.exp(jnp.sum(lambda_q2.astype(jnp.float32) * lambda_k2.astype(jnp.float32)))
           + lambda_init)
    o_b = diff_attention(q1, q2, k1, k2, vb, lam)
    o_b = (rmsnorm(o_b, subln_g) * (1.0 - lambda_init)).reshape(bsz, tp, B_V_WIDTH)

    merged = jax.nn.sigmoid(ga) * (o_a @ w_up_a) + jax.nn.sigmoid(gb) * (o_b @ w_up_b)
    return merged @ w_out


def clamped_swiglu(u):
    x_glu = jnp.minimum(u[..., ::2], SWIGLU_LIMIT)
    x_lin = jnp.clip(u[..., 1::2], -SWIGLU_LIMIT, SWIGLU_LIMIT)
    return x_glu * jax.nn.sigmoid(SWIGLU_ALPHA * x_glu) * (x_lin + 1.0)


def moe_ffn(h, w_router, b_router, w1, b1, w2, b2):
    n_tok, d = h.shape
    logits = (h @ w_router + b_router).astype(jnp.float32)
    top_val, top_idx = lax.top_k(logits, TOP_K)
    gate = jax.nn.softmax(top_val, axis=-1)
    n_assign = n_tok * TOP_K
    flat_e = top_idx.reshape(-1)
    flat_tok = jnp.arange(n_assign, dtype=jnp.int32) // TOP_K
    order = jnp.argsort(flat_e, stable=True)
    e_sorted = flat_e[order]
    tok_sorted = flat_tok[order]
    gate_sorted = gate.reshape(-1)[order]
    counts = jnp.bincount(flat_e, length=N_EXPERTS)
    padded = (counts + MOE_BLOCK - 1) // MOE_BLOCK * MOE_BLOCK
    pad_end = jnp.cumsum(padded)
    pad_start = pad_end - padded
    start = jnp.cumsum(counts) - counts
    dest = pad_start[e_sorted] + jnp.arange(n_assign) - start[e_sorted]
    n_blocks = (n_assign + N_EXPERTS * (MOE_BLOCK - 1) + MOE_BLOCK - 1) // MOE_BLOCK
    n_rows = n_blocks * MOE_BLOCK
    row_tok = jnp.full((n_rows,), n_tok, dtype=jnp.int32).at[dest].set(tok_sorted)
    h_ext = jnp.concatenate([h, jnp.zeros((1, d), h.dtype)], axis=0)
    xb = h_ext[row_tok].reshape(n_blocks, MOE_BLOCK, d)
    block_e = jnp.minimum(jnp.searchsorted(pad_end, jnp.arange(n_blocks) * MOE_BLOCK, side='right'),
                          N_EXPERTS - 1)

    def expert_block(args):
        x_blk, e = args
        u = x_blk @ w1[e] + b1[e]
        return clamped_swiglu(u) @ w2[e] + b2[e]

    yb = lax.map(expert_block, (xb, block_e)).reshape(n_rows, d)
    y_assign = yb[dest] * gate_sorted[:, None].astype(yb.dtype)
    return jax.ops.segment_sum(y_assign, tok_sorted, num_segments=n_tok)


def setup_inputs(seed: int = 0) -> dict:
    key = jax.random.key(seed)
    ks = jax.random.split(key, 20)
    f32 = jnp.float32
    nrm = lambda k, shape, s: jax.random.normal(k, shape, f32) * s
    return {
        'x': nrm(ks[0], (BATCH, SEQ, D_MODEL), 1.0),
        'meta_tokens': nrm(ks[1], (N_META, D_MODEL), 1.0),
        'norm_mix_g': 1.0 + nrm(ks[2], (DEPTH, D_MODEL), 0.01),
        'w_in': nrm(ks[3], (DEPTH, D_MODEL, D_IN), D_MODEL ** -0.5),
        'lambda_q1': nrm(ks[4], (DEPTH, HEAD_DIM), 0.1),
        'lambda_k1': nrm(ks[5], (DEPTH, HEAD_DIM), 0.1),
        'lambda_q2': nrm(ks[6], (DEPTH, HEAD_DIM), 0.1),
        'lambda_k2': nrm(ks[7], (DEPTH, HEAD_DIM), 0.1),
        'subln_g': 1.0 + nrm(ks[8], (DEPTH, 2 * HEAD_DIM), 0.01),
        'w_up_a': nrm(ks[9], (DEPTH, A_WIDTH, D_MODEL), A_WIDTH ** -0.5),
        'w_up_b': nrm(ks[10], (DEPTH, B_V_WIDTH, D_MODEL), B_V_WIDTH ** -0.5),
        'w_out': nrm(ks[11], (DEPTH, D_MODEL, D_MODEL), D_MODEL ** -0.5),
        'norm_ffn_g': 1.0 + nrm(ks[12], (DEPTH, D_MODEL), 0.01),
        'w_router': nrm(ks[13], (DEPTH, D_MODEL, N_EXPERTS), D_MODEL ** -0.5),
        'b_router': nrm(ks[14], (DEPTH, N_EXPERTS), 0.01),
        'w1': nrm(ks[15], (DEPTH, N_EXPERTS, D_MODEL, 2 * D_FF), D_MODEL ** -0.5),
        'b1': nrm(ks[16], (DEPTH, N_EXPERTS, 2 * D_FF), 0.01),
        'w2': nrm(ks[17], (DEPTH, N_EXPERTS, D_FF, D_MODEL), D_FF ** -0.5),
        'b2': nrm(ks[18], (DEPTH, N_EXPERTS, D_MODEL), 0.01),
        'norm_final_g': 1.0 + nrm(ks[19], (D_MODEL,), 0.01),
    }


def reference(x, meta_tokens, norm_mix_g, w_in, lambda_q1, lambda_k1, lambda_q2, lambda_k2, subln_g,
              w_up_a, w_up_b, w_out, norm_ffn_g, w_router, b_router, w1, b1, w2, b2, norm_final_g):
    bsz, s_len, _ = x.shape
    meta = jnp.broadcast_to(meta_tokens[None].astype(x.dtype), (bsz, N_META, D_MODEL))
    h = jnp.concatenate([meta, x], axis=1)
    t_len = s_len + N_META
    t_pad = -(-t_len // Q_BLOCK) * Q_BLOCK
    topk = min(TOPK_MAX, t_len // 4)
    cos, sin = rope_tables(t_pad, HEAD_DIM)
    cos_i, sin_i = rope_tables(t_pad, IDX_DIM)
    for l in range(DEPTH):
        lambda_init = 0.8 - 0.6 * math.exp(-0.3 * l)
        hn = jnp.pad(rmsnorm(h, norm_mix_g[l]), ((0, 0), (0, t_pad - t_len), (0, 0)))
        mix = hybrid_mixer(hn, w_in[l], lambda_q1[l], lambda_k1[l], lambda_q2[l], lambda_k2[l], subln_g[l],
                           w_up_a[l], w_up_b[l], w_out[l], cos, sin, cos_i, sin_i, topk, lambda_init)
        h = h + mix[:, :t_len]
        hf = rmsnorm(h, norm_ffn_g[l]).reshape(bsz * t_len, D_MODEL)
        y = moe_ffn(hf, w_router[l], b_router[l], w1[l], b1[l], w2[l], b2[l])
        h = h + y.reshape(bsz, t_len, D_MODEL)
    h = rmsnorm(h, norm_final_g)
    return h[:, N_META:]
```

```cpp
#include <hip/hip_runtime.h>
#include <cstdio>
#include <cstdint>
#include <cmath>

namespace mk {
#define LAS __attribute__((address_space(3)))
#define GAS __attribute__((address_space(1)))
typedef unsigned short bf16_t;
typedef short bf16x8 __attribute__((ext_vector_type(8)));
typedef float f32x4 __attribute__((ext_vector_type(4)));
typedef float f32x2 __attribute__((ext_vector_type(2)));
typedef unsigned u32x4 __attribute__((ext_vector_type(4)));
typedef unsigned u32x2 __attribute__((ext_vector_type(2)));

constexpr int NWAVES = 8, NTHR = 512;
constexpr int D = 2048, SEQ = 8192, NX = 16384, NMETA = 16, T = 8208, TP = 8256;
constexpr int MROWS = 16640;
constexpr int NIN = 11520;
constexpr int DIN = 11344;
constexpr int NE = 32, DFF = 2048;
constexpr float EPS = 1e-5f;
constexpr size_t al256(size_t x) { return (x + 255) & ~(size_t)255; }
constexpr size_t WS_CTL = 0, CTL_BYTES = 1u << 20;
constexpr size_t WS_ROPE = WS_CTL + CTL_BYTES;
constexpr size_t WS_ROPEI = WS_ROPE + al256((size_t)T * 64 * 8);
constexpr size_t WS_WIN = WS_ROPEI + al256((size_t)T * 32 * 8);
constexpr size_t WS_WUPA = WS_WIN + (size_t)NIN * D * 2;
constexpr size_t WS_WUPB = WS_WUPA + (size_t)D * 1024 * 2;
constexpr size_t WS_WOUT = WS_WUPB + (size_t)D * 1024 * 2;
constexpr size_t WS_W1 = WS_WOUT + (size_t)D * D * 2;
constexpr size_t WS_W2 = WS_W1 + (size_t)NE * 4096 * D * 2;
constexpr size_t WS_WR = WS_W2 + (size_t)NE * D * DFF * 2;
constexpr size_t WS_HN = WS_WR + (size_t)2 * NE * D * 2;
constexpr size_t WS_QA = WS_HN + (size_t)MROWS * D * 2;
constexpr size_t WS_KA = WS_QA + (size_t)NX * 1024 * 2;
constexpr size_t WS_VA = WS_KA + (size_t)2 * TP * 1024 * 2;
constexpr size_t WS_QI = WS_VA + (size_t)2 * TP * 1024 * 2;
constexpr size_t WS_KI = WS_QI + (size_t)NX * 1024 * 2;
constexpr size_t WS_WI = WS_KI + (size_t)2 * TP * 64 * 2;
constexpr size_t WS_QB = WS_WI + (size_t)NX * 16 * 4;
constexpr size_t WS_KB = WS_QB + (size_t)NX * 1024 * 2;
constexpr size_t WS_VB = WS_KB + (size_t)2 * TP * 1024 * 2;
constexpr size_t WS_GA = WS_VB + (size_t)2 * TP * 1024 * 2;
constexpr size_t WS_GB = WS_GA + (size_t)NX * D * 2;
constexpr size_t WS_END1 = WS_GB + (size_t)NX * D * 2;
constexpr int GATE_TILE0 = 28, GATE_COL0 = 7248;
constexpr int MAXL = 16384;
constexpr int MAXT = 288;
constexpr size_t WS_OA = WS_END1;
constexpr size_t WS_OB = WS_OA + (size_t)NX * 1024 * 2;
constexpr size_t WS_MGF = WS_OB + (size_t)NX * 1024 * 2;
constexpr size_t WS_MG = WS_MGF + (size_t)NX * D * 4;
constexpr size_t WS_H1 = WS_MG + (size_t)NX * D * 2;
constexpr size_t WS_HB = WS_H1 + (size_t)NX * D * 4;
constexpr size_t WS_GATE = WS_HB + (size_t)NX * D * 2;
constexpr size_t WS_SEI = WS_GATE + (size_t)NX * 4 * 4;
constexpr size_t WS_LIST = WS_SEI + (size_t)NX * 4 * 4;
constexpr size_t WS_G = WS_LIST + (size_t)NE * MAXL * 4;
constexpr size_t WS_Y = WS_G + (size_t)MAXT * 256 * DFF * 2;
constexpr size_t WS_MASK = WS_Y + (size_t)MAXT * 256 * D * 2;
constexpr size_t WS_OALL = WS_MASK + al256((size_t)NX * 129 * 8);
constexpr size_t WS_SC = WS_OALL + (size_t)NX * 3072 * 2;
constexpr size_t WS_END2 = WS_SC + (size_t)NX * TP * 4;

constexpr size_t WS_WIN8 = WS_OA, WS_HN8 = WS_MGF;
constexpr size_t WS_OA8 = WS_SC;
constexpr float OA8_SCALE = 16.0f;
constexpr int CW_BAR = 4096;
constexpr int CW_CNT = 65536;

constexpr int RING_OFF = 0, RING_BYTES = 131072;
constexpr int LDSCTL_OFF = RING_BYTES, MISC_OFF = LDSCTL_OFF + 320;
constexpr int MOE_TB_OFF = LDSCTL_OFF + 1024, MOE_CNT_OFF = LDSCTL_OFF + 1280;
constexpr int LDS_BYTES = 163840;

typedef __bf16 bf16x2_t __attribute__((ext_vector_type(2)));
__device__ __forceinline__ unsigned cvt_pk_bf16(float lo, float hi) { f32x2 v = {lo, hi}; bf16x2_t b = __builtin_convertvector(v, bf16x2_t); return __builtin_bit_cast(unsigned, b); }
typedef int i32x4 __attribute__((ext_vector_type(4)));
typedef int i32x8 __attribute__((ext_vector_type(8)));
constexpr float F8_WSCALE = 64.0f, F8_WINV = 1.0f / 64.0f;
__device__ __forceinline__ unsigned cvt4_fp8(float a, float b, float c, float d) { int w = 0; w = __builtin_amdgcn_cvt_pk_fp8_f32(a, b, w, false); w = __builtin_amdgcn_cvt_pk_fp8_f32(c, d, w, true); return (unsigned)w; }
__device__ __forceinline__ float bf2f(bf16_t b) { return __uint_as_float(((unsigned)b) << 16); }
__device__ __forceinline__ unsigned f2bf(float f) { unsigned u = __float_as_uint(f); return (u + 0x7fffu + ((u >> 16) & 1u)) >> 16; }
__device__ __forceinline__ int fresh_lane() { int l = (int)__builtin_amdgcn_mbcnt_hi(~0u, __builtin_amdgcn_mbcnt_lo(~0u, 0u)); asm volatile("" : "+v"(l)); return l; }
#define LDS_WAIT() asm volatile("s_waitcnt lgkmcnt(0)" ::: "memory")
#define VM_WAIT() asm volatile("s_waitcnt vmcnt(0)" ::: "memory")

#define XB_TMO      128
#define XB_XCNT(j)  (256  + 64 * (j))
#define XB_XSUB(j)  (1280 + 64 * (j))
#define XB_XGEN(j)  (2304 + 64 * (j))
#define XB_TOP      3328
#define XB_TOPGEN   3392
#define XCD_BAR_WORDS 3456
#define XB_SPIN_CAP (1u << 18)
__device__ __forceinline__ unsigned xb_ld(unsigned* p)              { return __hip_atomic_load(p, __ATOMIC_RELAXED, __HIP_MEMORY_SCOPE_AGENT); }
__device__ __forceinline__ unsigned xb_add(unsigned* p, unsigned v) { return __hip_atomic_fetch_add(p, v, __ATOMIC_RELAXED, __HIP_MEMORY_SCOPE_AGENT); }
__device__ __forceinline__ unsigned xb_xcc_id() { return (unsigned)__builtin_amdgcn_s_getreg((3 << 11) | 20) & 0xFu; }
#define XB_SPIN(cond, bar) do { unsigned _sp = 0; while (cond) { __builtin_amdgcn_s_sleep(1); \
    if ((++_sp & 255u) == 0u) { if (xb_ld(&(bar)[XB_TMO])) break; if (_sp > XB_SPIN_CAP) { atomicAdd(&(bar)[XB_TMO], 1u); break; } } } } while (0)
struct XcdBarrier { unsigned* bar; unsigned x; volatile LAS unsigned* st; int wave; };
__device__ __forceinline__ XcdBarrier xcd_barrier_post(unsigned* bar, volatile LAS unsigned* st) {
    XcdBarrier b; b.bar = bar; b.x = xb_xcc_id(); b.st = st;
    if (__builtin_amdgcn_readfirstlane(threadIdx.x >> 6) == 0 && fresh_lane() == 0) (void)xb_add(&bar[XB_XCNT(b.x)], 1u);
    return b;
}
__device__ __forceinline__ void xcd_barrier_complete(unsigned* bar, unsigned x, unsigned& nloc, unsigned& nx) {
    const unsigned G = gridDim.x * gridDim.y * gridDim.z;
    unsigned sum, cnt, mine, sp = 0u;
    for (;;) {
        sum = 0u; cnt = 0u; mine = 0u;
#pragma unroll
        for (unsigned j = 0; j < 16; ++j) { const unsigned c = xb_ld(&bar[XB_XCNT(j)]); sum += c; cnt += (c > 0u) ? 1u : 0u; mine = (j == x) ? c : mine; }
        if (sum == G) break;
        __builtin_amdgcn_s_sleep(1);
        if ((++sp & 255u) == 0u) { if (xb_ld(&bar[XB_TMO])) break; if (sp > XB_SPIN_CAP) { atomicAdd(&bar[XB_TMO], 1u); break; } }
    }
    nloc = mine > 0u ? mine : 1u; nx = cnt > 0u ? cnt : 1u;
}
__device__ __forceinline__ void xcd_barrier(const XcdBarrier& b) {
    asm volatile("s_waitcnt vmcnt(0)" ::: "memory");
    __syncthreads();
    if (b.wave == 0 && fresh_lane() == 0) {
        unsigned* bar = b.bar;
        __builtin_amdgcn_s_waitcnt(0);
        unsigned nloc = b.st[0], nx = b.st[1];
        if (nloc == 0u) { xcd_barrier_complete(bar, b.x, nloc, nx); b.st[0] = nloc; b.st[1] = nx; }
        const unsigned old = xb_add(&bar[XB_XSUB(b.x)], 1u);
        const unsigned gen = old / nloc;
        if (old + 1u == (gen + 1u) * nloc) {
            __builtin_amdgcn_fence(__ATOMIC_RELEASE, "agent");
            asm volatile("s_waitcnt vmcnt(0)" ::: "memory");
            const unsigned og = xb_add(&bar[XB_TOP], 1u);
            const unsigned tg = og / nx;
            if (og + 1u == (tg + 1u) * nx) xb_add(&bar[XB_TOPGEN], 1u);
            else XB_SPIN(xb_ld(&bar[XB_TOPGEN]) == tg, bar);
            __builtin_amdgcn_fence(__ATOMIC_ACQUIRE, "agent");
            xb_add(&bar[XB_XGEN(b.x)], 1u);
            asm volatile("s_waitcnt vmcnt(0)" ::: "memory");
        } else {
            XB_SPIN(xb_ld(&bar[XB_XGEN(b.x)]) == gen, bar);
            __builtin_amdgcn_fence(__ATOMIC_ACQUIRE, "agent");
            asm volatile("s_waitcnt vmcnt(0)" ::: "memory");
        }
    }
    __syncthreads();
}

constexpr int BM = 256, BK = 64, HALF = 128, HTB = HALF * BK * 2, STAGE_BYTES = 8 * HTB, NXCD = 8, WGM = 8;
__host__ __device__ __forceinline__ int lds_byte(int r, int c) { const int st = (r >> 4) * 2 + (c >> 5), rr = r & 15, cc = c & 31, ob = rr * 64 + cc * 2; return st * 1024 + (ob ^ (((ob >> 9) & 1) << 5)); }
__host__ __device__ __forceinline__ void stage_rc(int b, int& R, int& C) { const int st = b / 1024, sb = b % 1024, swz = sb ^ (((sb >> 9) & 1) << 5); R = (st >> 1) * 16 + swz / 64; C = (st & 1) * 32 + (swz % 64) / 2; }
__host__ __device__ __forceinline__ int perm32(int rho) { const int n = rho >> 4, i = rho & 15; return 8 * (i >> 2) + 4 * n + (i & 3); }
struct Unit { int pm, pn, ex; };
struct DenseOrder {
    int nM, nN, nwg, G, c;
    __device__ void init(int nM_, int nN_, int G_, int c_) { nM = nM_; nN = nN_; nwg = nM * nN; G = G_; c = c_; }
    __device__ bool next(int i, Unit& u) const {
        const long L = (long)i * G + c; if (L >= nwg) return false;
        int wgid = (int)L; { const int q = nwg / NXCD, r = nwg % NXCD, xcd = wgid % NXCD, off = wgid / NXCD; wgid = (xcd < r ? xcd * (q + 1) : r * (q + 1) + (xcd - r) * q) + off; }
        const int nig = WGM * nN, gid = wgid / nig, fm = gid * WGM, gsz = (nM - fm) < WGM ? (nM - fm) : WGM;
        u.pm = fm + ((wgid % nig) % gsz); u.pn = (wgid % nig) / gsz; u.ex = 0; return true;
    }
};
struct DenseAB {
    const char* Ab; const char* Bb; int K; int lda;
    __device__ __forceinline__ const char* a_base(const Unit& u) const { return Ab + (size_t)u.pm * 256 * lda * 2; }
    __device__ __forceinline__ const char* b_base(const Unit& u) const { return Bb + (size_t)u.pn * 256 * K * 2; }
    __device__ __forceinline__ void a_voff(const Unit&, const int (&R)[2], const int (&C)[2], unsigned (&v)[4]) const {
#pragma unroll
        for (int i = 0; i < 2; ++i) { v[i] = (unsigned)(R[i] * lda + C[i]) * 2u; v[2 + i] = (unsigned)((R[i] + HALF) * lda + C[i]) * 2u; } }
};

struct DenseAB8 {
    const char* Ab; const char* Bb; int KB; int ldaB; int pn0;
    __device__ __forceinline__ const char* a_base(const Unit& u) const { return Ab + (size_t)u.pm * 256 * ldaB; }
    __device__ __forceinline__ const char* b_base(const Unit& u) const { return Bb + (size_t)(u.pn - pn0) * 256 * KB; }
    __device__ __forceinline__ void a_voff(const Unit&, const int (&R)[2], const int (&C)[2], unsigned (&v)[4]) const {
#pragma unroll
        for (int i = 0; i < 2; ++i) { v[i] = (unsigned)(R[i] * ldaB + 2 * C[i]); v[2 + i] = (unsigned)((R[i] + HALF) * ldaB + 2 * C[i]); } }
};
struct WindowOrder { DenseOrder d; int pn0;
    __device__ void init(int nM, int nN, int pn0_, int G, int c) { d.init(nM, nN, G, c); pn0 = pn0_; }
    __device__ bool next(int i, Unit& u) const { if (!d.next(i, u)) return false; u.pn += pn0; return true; } };
template <class E_> struct has_mid { template <class T> static constexpr bool test(decltype(T::HAS_MID)*) { return T::HAS_MID; } template <class T> static constexpr bool test(...) { return false; } static constexpr bool value = test<E_>(nullptr); };
template <bool F8 = false, class Epi, class Sched, class AB>
__device__ __forceinline__ void gemm_phase(LAS unsigned char* lds, int KB, const Sched& S, const AB& P, const Epi& E, int wave_) {
    const int wid = wave_, lane = fresh_lane(), tid = wid * 64 + lane, wr = wid >> 2, wc = wid & 3, fr = lane & 15, fq = lane >> 4;
    const int nt = KB / (BK * 2);
    int Rr[2], Cc[2]; unsigned voffB[2];
#pragma unroll
    for (int i = 0; i < 2; ++i) { stage_rc(tid * 16 + i * 8192, Rr[i], Cc[i]); const int Rb = (Rr[i] & ~31) + perm32(Rr[i] & 31); voffB[i] = (unsigned)(Rb * KB + 2 * Cc[i]); }
    const size_t kstep = (size_t)(BK * 2);
    const size_t hstep = (size_t)HALF * KB;
    const unsigned ldsw = (unsigned)wid * 1024u;
    const int aoff = lds_byte(wr * 64 + fr, fq * 8), boff = lds_byte(wc * 32 + fr, fq * 8);
#define PG8_SA(b, h) (((b) * 2 + (h)) * HTB)
#define PG8_SB(b, h) ((4 + (b) * 2 + (h)) * HTB)
#define PG8_STAGE2(bufoff, gbase, v0, v1) do { \
        __builtin_amdgcn_global_load_lds((const unsigned*)((const char*)(gbase) + (v0)), (LAS unsigned*)(lds + (bufoff) + ldsw), 16, 0, 0); \
        __builtin_amdgcn_global_load_lds((const unsigned*)((const char*)(gbase) + (v1)), (LAS unsigned*)(lds + (bufoff) + ldsw + 8192), 16, 0, 0); } while (0)
#define PG8_STAGEB(bufoff, gbase) PG8_STAGE2(bufoff, gbase, voffB[0], voffB[1])
#define PG8_LDA(dst, b, h) do { _Pragma("unroll") for (int m = 0; m < 4; ++m) _Pragma("unroll") for (int k = 0; k < 2; ++k) dst[m][k] = *(const LAS bf16x8*)(lds + PG8_SA(b, h) + aoff + m * 2048 + k * 1024); } while (0)
#define PG8_LDB(dst, b, h) do { _Pragma("unroll") for (int n = 0; n < 2; ++n) _Pragma("unroll") for (int k = 0; k < 2; ++k) dst[n][k] = *(const LAS bf16x8*)(lds + PG8_SB(b, h) + boff + n * 2048 + k * 1024); } while (0)
#define PG8_CAT(x0, x1) __builtin_shufflevector(__builtin_bit_cast(i32x4, x0), __builtin_bit_cast(i32x4, x1), 0, 1, 2, 3, 4, 5, 6, 7)
#define PG8_MMA(ai, bj, At, Bt) do { __builtin_amdgcn_s_setprio(1); _Pragma("unroll") for (int m = 0; m < 4; ++m) _Pragma("unroll") for (int n = 0; n < 2; ++n) { \
        if constexpr (F8) { const i32x8 a8_ = PG8_CAT(Bt[n][0], Bt[n][1]), b8_ = PG8_CAT(At[m][0], At[m][1]);   \
            asm volatile("v_mfma_f32_16x16x128_f8f6f4 %0, %1, %2, %0" : "+v"(acc[ai][bj][m][n]) : "v"(a8_), "v"(b8_)); }     \
        else { _Pragma("unroll") for (int k = 0; k < 2; ++k) acc[ai][bj][m][n] = __builtin_amdgcn_mfma_f32_16x16x32_bf16(Bt[n][k], At[m][k], acc[ai][bj][m][n], 0, 0, 0); } } \
        __builtin_amdgcn_s_setprio(0); } while (0)
#define PG8_WAIT_V(n) asm volatile("s_waitcnt vmcnt(" #n ")" ::: "memory")
#define PG8_WAIT_L(n) asm volatile("s_waitcnt lgkmcnt(" #n ")" ::: "memory")
#define PG8_BAR __builtin_amdgcn_s_barrier()
#define PG8_SCHED __builtin_amdgcn_sched_barrier(0)
    Unit cur, nxt; int ui = 0;
    if (!S.next(0, cur)) return;
    f32x4 acc[2][2][4][2];
#pragma unroll
    for (int a = 0; a < 2; ++a)
#pragma unroll
        for (int b = 0; b < 2; ++b)
#pragma unroll
            for (int m = 0; m < 4; ++m)
#pragma unroll
                for (int n = 0; n < 2; ++n) acc[a][b][m][n] = (f32x4){0.f, 0.f, 0.f, 0.f};
    bf16x8 At[4][2], B0[2][2], B1[2][2];
    const int f8scale = 0x7f7f7f7f;
    const char* cA = P.a_base(cur); const char* cB = P.b_base(cur);
    unsigned cvo[4], nvo[4];
    P.a_voff(cur, Rr, Cc, cvo);
    PG8_STAGEB(PG8_SB(0, 0), cB); PG8_STAGEB(PG8_SB(0, 1), cB + hstep); PG8_STAGE2(PG8_SA(0, 0), cA, cvo[0], cvo[1]); PG8_STAGE2(PG8_SA(0, 1), cA, cvo[2], cvo[3]);
    if (wr == 1) PG8_BAR;
    PG8_WAIT_V(2); PG8_BAR;
    PG8_STAGEB(PG8_SB(1, 0), cB + kstep); PG8_STAGE2(PG8_SA(1, 0), cA + kstep, cvo[0], cvo[1]); PG8_STAGEB(PG8_SB(1, 1), cB + hstep + kstep);
    PG8_WAIT_V(6); PG8_BAR;
    for (;;) {
        const bool has_next = S.next(ui + 1, nxt);
        const char* nA = cA; const char* nB = cB;
#pragma unroll
        for (int i = 0; i < 4; ++i) nvo[i] = cvo[i];
        if (has_next) { nA = P.a_base(nxt); nB = P.b_base(nxt); P.a_voff(nxt, Rr, Cc, nvo); }
        for (int t = 0; t < nt; t += 2) {
            if constexpr (has_mid<Epi>::value) { if (t == nt / 2) { Epi& Em = const_cast<Epi&>(E); Em.mid(acc, cur, wr, wc, fr, fq); } }
            const bool last = (t == nt - 2);
            const char* a1 = cA + (size_t)(t + 1) * kstep;
            const char* a2 = last ? nA : cA + (size_t)(t + 2) * kstep; const char* b2 = last ? nB : cB + (size_t)(t + 2) * kstep;
            const char* a3 = a2 + kstep; const char* b3 = b2 + kstep;
            const unsigned x0 = last ? nvo[0] : cvo[0], x1 = last ? nvo[1] : cvo[1], x2 = last ? nvo[2] : cvo[2], x3 = last ? nvo[3] : cvo[3];
            PG8_LDB(B0, 0, 0); PG8_LDB(B1, 0, 1); PG8_SCHED; PG8_LDA(At, 0, 0); PG8_STAGE2(PG8_SA(1, 1), a1, cvo[2], cvo[3]);
            PG8_WAIT_V(8); PG8_WAIT_L(0); PG8_BAR; PG8_MMA(0, 0, At, B0); PG8_MMA(0, 1, At, B1); PG8_BAR; PG8_SCHED;
            PG8_LDA(At, 0, 1); PG8_STAGEB(PG8_SB(0, 0), b2); PG8_STAGEB(PG8_SB(0, 1), b2 + hstep); PG8_STAGE2(PG8_SA(0, 0), a2, x0, x1);
            PG8_WAIT_V(8); PG8_WAIT_L(0); PG8_BAR; PG8_MMA(1, 0, At, B0); PG8_MMA(1, 1, At, B1); PG8_BAR; PG8_SCHED;
            PG8_LDB(B0, 1, 0); PG8_LDB(B1, 1, 1); PG8_SCHED; PG8_LDA(At, 1, 0); PG8_STAGE2(PG8_SA(0, 1), a2, x2, x3);
            PG8_WAIT_V(8); PG8_WAIT_L(0); PG8_BAR; PG8_MMA(0, 0, At, B0); PG8_MMA(0, 1, At, B1); PG8_BAR; PG8_SCHED;
            PG8_LDA(At, 1, 1); PG8_STAGEB(PG8_SB(1, 0), b3); PG8_STAGEB(PG8_SB(1, 1), b3 + hstep); PG8_STAGE2(PG8_SA(1, 0), a3, x0, x1);
            PG8_WAIT_V(8); PG8_WAIT_L(0); PG8_BAR; PG8_MMA(1, 0, At, B0); PG8_MMA(1, 1, At, B1); PG8_BAR; PG8_SCHED;
        }
        if (wr == 0) PG8_BAR;
        E(acc, cur, wr, wc, fr, fq);
        if (!has_next) break;
#pragma unroll
        for (int a = 0; a < 2; ++a)
#pragma unroll
            for (int b = 0; b < 2; ++b)
#pragma unroll
                for (int m = 0; m < 4; ++m)
#pragma unroll
                    for (int n = 0; n < 2; ++n) acc[a][b][m][n] = (f32x4){0.f, 0.f, 0.f, 0.f};
        cur = nxt; cA = nA; cB = nB; ++ui;
#pragma unroll
        for (int i = 0; i < 4; ++i) cvo[i] = nvo[i];
        if (wr == 1) PG8_BAR;
    }
    PG8_WAIT_V(0);
    PG8_BAR;
#undef PG8_SA
#undef PG8_SB
#undef PG8_STAGE2
#undef PG8_STAGEB
#undef PG8_LDA
#undef PG8_LDB
#undef PG8_MMA
#undef PG8_CAT
#undef PG8_WAIT_V
#undef PG8_WAIT_L
#undef PG8_BAR
#undef PG8_SCHED
}

struct Frame {
    LAS unsigned char* lds; volatile LAS unsigned* MISC; unsigned* ctl;
    int wave, vcu, G;
    const float* in[20]; float* out; unsigned char* ws;
};
__device__ __forceinline__ float wave_sum(float v) {
#pragma unroll
    for (int o = 1; o < 64; o <<= 1) v += __shfl_xor(v, o);
    return v;
}

__host__ __device__ __forceinline__ int perm128(int c) { return ((c >> 6) & 1) * 128 + (c >> 7) * 64 + (c & 63); }
__host__ __device__ __forceinline__ int perm64(int c) { return ((c >> 5) & 1) * 128 + (c >> 6) * 32 + (c & 31); }
__host__ __device__ __forceinline__ int win_dest(int n) {
    if (n < 1024) return 0 * 256 + (n >> 8) * 256 + perm128(n & 255);
    if (n < 2048) { n -= 1024; return 4 * 256 + (n >> 8) * 256 + perm128(n & 255); }
    if (n < 3072) { n -= 2048; return 8 * 256 + n; }
    if (n < 4096) { n -= 3072; return 12 * 256 + (n >> 8) * 256 + perm64(n & 255); }
    if (n < 4160) { n -= 4096; return 44 * 256 + (n >> 5) * 128 + (n & 31); }
    if (n < 4176) { n -= 4160; return 44 * 256 + 64 + n; }
    if (n < 5200) { n -= 4176; return 16 * 256 + (n >> 8) * 256 + perm128(n & 255); }
    if (n < 6224) { n -= 5200; return 20 * 256 + (n >> 8) * 256 + perm128(n & 255); }
    if (n < 7248) { n -= 6224; return 24 * 256 + n; }
    if (n < 9296) { n -= 7248; return 28 * 256 + n; }
    n -= 9296; return 36 * 256 + n;
}

template <class DestFn>
__device__ __forceinline__ void p0_transpose_item(const float* W, int K, int N, bf16_t* WT, LAS float* scr, int item, int lane, DestFn dest, int pitch = 0) {
    if (pitch == 0) pitch = K;
    const int nblk = (N + 31) / 32, kb = item / nblk, nb = item % nblk, k0 = 64 * kb, n0 = 32 * nb;
    { const int lr = lane >> 3, lc = 4 * (lane & 7); const bool nok = (n0 + lc) < N;
      const float* wp = W + (size_t)(k0 + lr) * N + n0 + lc; f32x4 t[8];
#pragma unroll
      for (int i = 0; i < 8; ++i) t[i] = nok ? *(const f32x4*)(wp + (size_t)(8 * i) * N) : (f32x4){0.f, 0.f, 0.f, 0.f};
#pragma unroll
      for (int i = 0; i < 8; ++i) { LAS float* sp = scr + (8 * i + lr) * 33 + lc; sp[0] = t[i][0]; sp[1] = t[i][1]; sp[2] = t[i][2]; sp[3] = t[i][3]; } }
    LDS_WAIT(); asm volatile("" ::: "memory");
    const int c = lane & 7;
#pragma unroll
    for (int j = 0; j < 4; ++j) { const int n = (lane >> 3) + 8 * j; const LAS float* s = scr + (8 * c) * 33 + n;
        u32x4 o; o.x = cvt_pk_bf16(s[0 * 33], s[1 * 33]); o.y = cvt_pk_bf16(s[2 * 33], s[3 * 33]); o.z = cvt_pk_bf16(s[4 * 33], s[5 * 33]); o.w = cvt_pk_bf16(s[6 * 33], s[7 * 33]);
        if (n0 + n < N) *(GAS u32x4*)(WT + (size_t)dest(n0 + n) * pitch + k0 + 8 * c) = o; }
    LDS_WAIT(); asm volatile("" ::: "memory");
}
struct DestId { __device__ __forceinline__ int operator()(int n) const { return n; } };
struct DestWin { __device__ __forceinline__ int operator()(int n) const { return win_dest(n); } };
struct DestWin8 { __device__ __forceinline__ int operator()(int n) const { return n >= GATE_COL0 ? win_dest(n) - GATE_TILE0 * 256 : -1; } };
template <class DestFn>
__device__ __forceinline__ void p0_transpose_item_f8(const float* W, int K, int N, unsigned char* WT, LAS float* scr, int item, int lane, DestFn dest, int pitch = 0) {
    if (pitch == 0) pitch = K;
    const int nblk = (N + 31) / 32, kb = item / nblk, nb = item % nblk, k0 = 64 * kb, n0 = 32 * nb;
    { const int lr = lane >> 3, lc = 4 * (lane & 7); const bool nok = (n0 + lc) < N;
      const float* wp = W + (size_t)(k0 + lr) * N + n0 + lc; f32x4 t[8];
#pragma unroll
      for (int i = 0; i < 8; ++i) t[i] = nok ? *(const f32x4*)(wp + (size_t)(8 * i) * N) : (f32x4){0.f, 0.f, 0.f, 0.f};
#pragma unroll
      for (int i = 0; i < 8; ++i) { LAS float* sp = scr + (8 * i + lr) * 33 + lc; sp[0] = t[i][0]; sp[1] = t[i][1]; sp[2] = t[i][2]; sp[3] = t[i][3]; } }
    LDS_WAIT(); asm volatile("" ::: "memory");
    const int c = lane & 7;
#pragma unroll
    for (int j = 0; j < 4; ++j) { const int n = (lane >> 3) + 8 * j; const LAS float* s = scr + (8 * c) * 33 + n;
        u32x2 o; o.x = cvt4_fp8(s[0 * 33] * F8_WSCALE, s[1 * 33] * F8_WSCALE, s[2 * 33] * F8_WSCALE, s[3 * 33] * F8_WSCALE); o.y = cvt4_fp8(s[4 * 33] * F8_WSCALE, s[5 * 33] * F8_WSCALE, s[6 * 33] * F8_WSCALE, s[7 * 33] * F8_WSCALE);
        const int dr = (n0 + n < N) ? dest(n0 + n) : -1;
        if (dr >= 0) *(GAS u32x2*)(WT + (size_t)dr * pitch + k0 + 8 * c) = o; }
    LDS_WAIT(); asm volatile("" ::: "memory");
}

__device__ __forceinline__ void zero_row_bf16(bf16_t* p, int nelem, int lane) {
    for (int i = lane * 8; i < nelem; i += 512) *(GAS u32x4*)(p + i) = (u32x4){0u, 0u, 0u, 0u};
}

__device__ __forceinline__ void p0_prologue(Frame& F) {
    const int lane_ = fresh_lane();
    LAS float* scr = (LAS float*)(F.lds + RING_OFF + F.wave * 16384);
    const int gw = F.vcu * NWAVES + F.wave, NGW = F.G * NWAVES;
    const float* x = F.in[0]; const float* meta = F.in[1]; const float* g_mix = F.in[2]; const float* w_in = F.in[3];
    const float* w_up_a = F.in[9]; const float* w_up_b = F.in[10]; const float* w_out = F.in[11]; const float* g_ffn = F.in[12]; const float* w_router = F.in[13];
    unsigned char* ws = F.ws;
    const float* w1 = F.in[15]; const float* w2 = F.in[17];
    constexpr int I_IN = (D / 64) * ((DIN + 31) / 32), I_UP = (1024 / 64) * (D / 32), I_OUT = (D / 64) * (D / 32), I_W1 = (D / 64) * (4096 / 32), I_W2 = (DFF / 64) * (D / 32);
    constexpr int NITEMS = I_IN;
    for (int it = gw; it < NITEMS; it += NGW) {
        int r = it;
        if (r < I_IN) { const int n0_ = 32 * (r % ((DIN + 31) / 32));
            if (n0_ < GATE_COL0) p0_transpose_item(w_in, D, DIN, (bf16_t*)(ws + WS_WIN), scr, r, lane_, DestWin());
            if (n0_ + 31 >= GATE_COL0) p0_transpose_item_f8(w_in, D, DIN, ws + WS_WIN8, scr, r, lane_, DestWin8());
            continue; } r -= I_IN;
    }
    {
        constexpr int J0 = 176, J1 = J0 + 240, J2 = J1 + 4 * 96, J3 = J2 + 96;
        for (int j = gw; j < J3; j += NGW) {
            if (j < J0) { int s = j; int slot = s < 32 ? 32 + s : (s < 32 + 48 ? 80 + (s - 32) : 160 + (s - 80)); zero_row_bf16((bf16_t*)(ws + WS_WIN) + (size_t)(44 * 256 + slot) * D, D, lane_); }
            else if (j < J1) { zero_row_bf16((bf16_t*)(ws + WS_HN) + (size_t)(NX + NMETA + (j - J0)) * D, D, lane_); }
            else if (j < J2) { const int q = j - J1, which = q / 96, rr = q % 96, b = rr / 48, p = T + rr % 48;
                const size_t base = which == 0 ? WS_KA : which == 1 ? WS_VA : which == 2 ? WS_KB : WS_VB;
                zero_row_bf16((bf16_t*)(ws + base) + ((size_t)b * TP + p) * 1024, 1024, lane_); }
            else { const int rr = j - J2, b = rr / 48, p = T + rr % 48; zero_row_bf16((bf16_t*)(ws + WS_KI) + ((size_t)b * TP + p) * 64, 64, lane_); }
        }
    }
    {
        const int gt = gw * 64 + lane_, NGT = NGW * 64;
        f32x2* rope = (f32x2*)(ws + WS_ROPE); f32x2* ropei = (f32x2*)(ws + WS_ROPEI);
        for (int i = gt; i < T * 64; i += NGT) { const int pos = i >> 6, fi = i & 63; const double ang = (double)pos * pow(10000.0, -(double)fi / 64.0); rope[i] = (f32x2){(float)cos(ang), (float)sin(ang)}; }
        for (int i = gt; i < T * 32; i += NGT) { const int pos = i >> 5, fi = i & 31; const double ang = (double)pos * pow(10000.0, -(double)fi / 32.0); ropei[i] = (f32x2){(float)cos(ang), (float)sin(ang)}; }
        bf16_t* wrh = (bf16_t*)(ws + WS_WR); bf16_t* wrl = wrh + NE * D;
        for (int i = gt; i < NE * D; i += NGT) { const int e = i / D, k = i % D; const float v = g_ffn[k] * w_router[(size_t)k * NE + e]; const unsigned h = f2bf(v); const float hv = __uint_as_float(h << 16);
            wrh[i] = (bf16_t)h; wrl[i] = (bf16_t)f2bf(v - hv); }
    }
    for (int r = gw; r < NX + NMETA; r += NGW) {
        const float* src = r < NX ? x + (size_t)r * D : meta + (size_t)(r - NX) * D;
        const GAS f32x4* xr = (const GAS f32x4*)src + lane_; const GAS f32x4* gr = (const GAS f32x4*)g_mix + lane_;
        f32x4 v[8]; float s = 0.f;
#pragma unroll
        for (int j = 0; j < 8; ++j) { v[j] = xr[64 * j]; s += (v[j].x * v[j].x + v[j].y * v[j].y) + (v[j].z * v[j].z + v[j].w * v[j].w); }
        const float rs = 1.0f / sqrtf(wave_sum(s) * (1.f / D) + EPS);
        GAS u32x2* o8 = (GAS u32x2*)((bf16_t*)(ws + WS_HN) + (size_t)r * D) + lane_;
        GAS unsigned* o4 = (GAS unsigned*)(ws + WS_HN8 + (size_t)r * D) + lane_;
#pragma unroll
        for (int j = 0; j < 8; ++j) { const f32x4 g = gr[64 * j]; const float y0 = v[j].x * rs * g.x, y1 = v[j].y * rs * g.y, y2 = v[j].z * rs * g.z, y3 = v[j].w * rs * g.w;
            u32x2 w; w.x = cvt_pk_bf16(y0, y1); w.y = cvt_pk_bf16(y2, y3); o8[64 * j] = w; o4[64 * j] = cvt4_fp8(y0, y1, y2, y3); }
    }
}

struct EpiInProj {
    unsigned char* ws; float sc;
    template <int MODE>
    __device__ __forceinline__ void store_tile(const f32x4 (&acc)[2][2][4][2], bf16_t* dst, int ld, int colbase, size_t rowbase, int nvalid, int pos0, size_t dupoff, int wr, int wc, int fr, int fq) const {
        const f32x2* rope = (const f32x2*)(ws + WS_ROPE); const f32x2* ropei = (const f32x2*)(ws + WS_ROPEI);
#pragma unroll
        for (int ai = 0; ai < 2; ++ai)
#pragma unroll
            for (int m = 0; m < 4; ++m) {
                const int tr = ai * HALF + wr * 64 + m * 16 + fr;
                if (tr < nvalid) {
                    bf16_t* rowp = dst + (rowbase + tr) * (size_t)ld + colbase;
                    if (MODE == 0 || MODE == 1) {
#pragma unroll
                        for (int bj = 0; bj < 2; ++bj) { f32x4 v0 = acc[ai][bj][m][0] * sc, v1 = acc[ai][bj][m][1] * sc;
                            if (MODE == 1) {
#pragma unroll
                                for (int j = 0; j < 4; ++j) { v0[j] = __builtin_amdgcn_rcpf(1.f + __builtin_amdgcn_exp2f(-1.4426950408889634f * v0[j])); v1[j] = __builtin_amdgcn_rcpf(1.f + __builtin_amdgcn_exp2f(-1.4426950408889634f * v1[j])); } }
                            u32x4 w; w.x = cvt_pk_bf16(v0[0], v0[1]); w.y = cvt_pk_bf16(v0[2], v0[3]); w.z = cvt_pk_bf16(v1[0], v1[1]); w.w = cvt_pk_bf16(v1[2], v1[3]);
                            *(u32x4*)(rowp + bj * HALF + wc * 32 + 8 * fq) = w; if (dupoff) *(u32x4*)(rowp + dupoff + bj * HALF + wc * 32 + 8 * fq) = w; }
                    } else {
                        const int pos = pos0 + tr;
                        const int i0 = MODE == 2 ? (wc & 1) * 32 + 8 * fq : 8 * fq;
                        const int col = MODE == 2 ? (wc >> 1) * 128 + i0 : wc * 64 + i0;
                        const int hw = MODE == 2 ? 64 : 32;
                        const f32x4* tp = (const f32x4*)((MODE == 2 ? rope + (size_t)pos * 64 : ropei + (size_t)pos * 32) + i0);
                        const f32x4 t0 = tp[0], t1 = tp[1], t2 = tp[2], t3 = tp[3];
                        const f32x4 a0 = acc[ai][0][m][0], a1 = acc[ai][0][m][1], b0 = acc[ai][1][m][0], b1 = acc[ai][1][m][1];
                        float y1[8], y2[8];
                        y1[0] = a0[0] * t0[0] - b0[0] * t0[1]; y2[0] = b0[0] * t0[0] + a0[0] * t0[1];
                        y1[1] = a0[1] * t0[2] - b0[1] * t0[3]; y2[1] = b0[1] * t0[2] + a0[1] * t0[3];
                        y1[2] = a0[2] * t1[0] - b0[2] * t1[1]; y2[2] = b0[2] * t1[0] + a0[2] * t1[1];
                        y1[3] = a0[3] * t1[2] - b0[3] * t1[3]; y2[3] = b0[3] * t1[2] + a0[3] * t1[3];
                        y1[4] = a1[0] * t2[0] - b1[0] * t2[1]; y2[4] = b1[0] * t2[0] + a1[0] * t2[1];
                        y1[5] = a1[1] * t2[2] - b1[1] * t2[3]; y2[5] = b1[1] * t2[2] + a1[1] * t2[3];
                        y1[6] = a1[2] * t3[0] - b1[2] * t3[1]; y2[6] = b1[2] * t3[0] + a1[2] * t3[1];
                        y1[7] = a1[3] * t3[2] - b1[3] * t3[3]; y2[7] = b1[3] * t3[2] + a1[3] * t3[3];
                        u32x4 w1, w2; w1.x = cvt_pk_bf16(y1[0], y1[1]); w1.y = cvt_pk_bf16(y1[2], y1[3]); w1.z = cvt_pk_bf16(y1[4], y1[5]); w1.w = cvt_pk_bf16(y1[6], y1[7]);
                        w2.x = cvt_pk_bf16(y2[0], y2[1]); w2.y = cvt_pk_bf16(y2[2], y2[3]); w2.z = cvt_pk_bf16(y2[4], y2[5]); w2.w = cvt_pk_bf16(y2[6], y2[7]);
                        *(u32x4*)(rowp + col) = w1; *(u32x4*)(rowp + col + hw) = w2; if (dupoff) { *(u32x4*)(rowp + dupoff + col) = w1; *(u32x4*)(rowp + dupoff + col + hw) = w2; }
                    }
                }
                asm volatile("" ::: "memory");
            }
    }
    __device__ __forceinline__ void operator()(const f32x4 (&acc)[2][2][4][2], const Unit& u, int wr, int wc, int fr, int fq) const {
        const int pn = u.pn, pm = u.pm;
        const int sec = pn < 28 ? (pn >> 2) : (pn < 36 ? 7 : (pn < 44 ? 8 : 9));
        const int mode = (sec == 2 || sec == 6) ? 0 : ((sec == 7 || sec == 8) ? 1 : ((sec == 3 || sec == 9) ? 3 : 2));
        const int kt = (sec == 1 || sec == 2 || sec == 5 || sec == 6 || sec == 9) ? 1 : 0;
        const int ld = (sec == 7 || sec == 8) ? 2048 : (sec == 9 ? 64 : 1024);
        const int colbase = sec < 7 ? (pn & 3) * 256 : (sec == 7 ? (pn - 28) * 256 : (sec == 8 ? (pn - 36) * 256 : 0));
        const size_t off = sec == 0 ? WS_QA : sec == 1 ? WS_KA : sec == 2 ? WS_VA : sec == 3 ? WS_QI : sec == 4 ? WS_QB : sec == 5 ? WS_KB : sec == 6 ? WS_VB : sec == 7 ? WS_GA : sec == 8 ? WS_GB : WS_KI;
        if (sec == 9 && pm < 64 && wc == 2 && fq < 2) {
            float* WI = (float*)(ws + WS_WI);
#pragma unroll
            for (int ai = 0; ai < 2; ++ai)
#pragma unroll
                for (int m = 0; m < 4; ++m) { const int r = pm * 256 + ai * HALF + wr * 64 + m * 16 + fr;
                    *(f32x4*)(WI + (size_t)r * 16 + 8 * fq) = acc[ai][0][m][0] * (1.0f / 32.0f); *(f32x4*)(WI + (size_t)r * 16 + 8 * fq + 4) = acc[ai][0][m][1] * (1.0f / 32.0f); }
        }
        const bool meta = pm >= 64;
        const bool active = (sec != 9 || wc == 0) && (kt != 0 || !meta);
        bf16_t* dst = (bf16_t*)(ws + off);
        const int pos0 = meta ? 0 : NMETA + (pm & 31) * 256;
        const int nvalid = active ? (meta ? NMETA : 256) : 0;
        const size_t rowbase = meta ? (size_t)0 : (kt ? (size_t)(pm >> 5) * TP + pos0 : (size_t)pm * 256);
        const size_t dupoff = meta ? (size_t)TP * ld : (size_t)0;
        if (mode == 0) store_tile<0>(acc, dst, ld, colbase, rowbase, nvalid, pos0, dupoff, wr, wc, fr, fq);
        else if (mode == 1) store_tile<1>(acc, dst, ld, colbase, rowbase, nvalid, pos0, dupoff, wr, wc, fr, fq);
        else if (mode == 2) store_tile<2>(acc, dst, ld, colbase, rowbase, nvalid, pos0, dupoff, wr, wc, fr, fq);
        else store_tile<3>(acc, dst, ld, colbase, rowbase, nvalid, pos0, dupoff, wr, wc, fr, fq);
    }
};


struct EpiUp {
    static constexpr bool HAS_MID = true;
    const bf16_t* GA; const bf16_t* GB; unsigned char* MG; float msc, esc;
    __device__ __forceinline__ void mid(f32x4 (&acc)[2][2][4][2], const Unit& u, int wr, int wc, int fr, int fq) const {
        asm volatile("" : "+v"(fr), "+v"(fq));
#pragma unroll
        for (int ai = 0; ai < 2; ++ai)
#pragma unroll
            for (int m = 0; m < 4; ++m) { const size_t ro = (size_t)(u.pm * 256 + ai * HALF + wr * 64 + m * 16 + fr) * D + u.pn * 256 + wc * 32 + 8 * fq;
#pragma unroll
                for (int bj = 0; bj < 2; ++bj) { const u32x4 a = *(const u32x4*)(GA + ro + bj * HALF), b = *(const u32x4*)(GB + ro + bj * HALF);
                    f32x4& v0 = acc[ai][bj][m][0]; f32x4& v1 = acc[ai][bj][m][1];
                    v0[0] *= msc * __uint_as_float(a.x << 16) * __builtin_amdgcn_rcpf(__uint_as_float(b.x << 16)); v0[1] *= msc * __uint_as_float(a.x & 0xffff0000u) * __builtin_amdgcn_rcpf(__uint_as_float(b.x & 0xffff0000u));
                    v0[2] *= msc * __uint_as_float(a.y << 16) * __builtin_amdgcn_rcpf(__uint_as_float(b.y << 16)); v0[3] *= msc * __uint_as_float(a.y & 0xffff0000u) * __builtin_amdgcn_rcpf(__uint_as_float(b.y & 0xffff0000u));
                    v1[0] *= msc * __uint_as_float(a.z << 16) * __builtin_amdgcn_rcpf(__uint_as_float(b.z << 16)); v1[1] *= msc * __uint_as_float(a.z & 0xffff0000u) * __builtin_amdgcn_rcpf(__uint_as_float(b.z & 0xffff0000u));
                    v1[2] *= msc * __uint_as_float(a.w << 16) * __builtin_amdgcn_rcpf(__uint_as_float(b.w << 16)); v1[3] *= msc * __uint_as_float(a.w & 0xffff0000u) * __builtin_amdgcn_rcpf(__uint_as_float(b.w & 0xffff0000u)); }
                asm volatile("" ::: "memory"); }
    }
    __device__ __forceinline__ void operator()(const f32x4 (&acc)[2][2][4][2], const Unit& u, int wr, int wc, int fr, int fq) const {
#pragma unroll
        for (int ai = 0; ai < 2; ++ai)
#pragma unroll
            for (int m = 0; m < 4; ++m) { const size_t ro = (size_t)(u.pm * 256 + ai * HALF + wr * 64 + m * 16 + fr) * D + u.pn * 256 + wc * 32 + 8 * fq;
#pragma unroll
                for (int bj = 0; bj < 2; ++bj) { const u32x4 g = *(const u32x4*)(GB + ro + bj * HALF);
                    const f32x4 v0 = acc[ai][bj][m][0] * esc, v1 = acc[ai][bj][m][1] * esc;
                    u32x2 w;
                    w.x = cvt4_fp8(v0[0] * __uint_as_float(g.x << 16), v0[1] * __uint_as_float(g.x & 0xffff0000u), v0[2] * __uint_as_float(g.y << 16), v0[3] * __uint_as_float(g.y & 0xffff0000u));
                    w.y = cvt4_fp8(v1[0] * __uint_as_float(g.z << 16), v1[1] * __uint_as_float(g.z & 0xffff0000u), v1[2] * __uint_as_float(g.w << 16), v1[3] * __uint_as_float(g.w & 0xffff0000u));
                    *(u32x2*)(MG + ro + bj * HALF) = w; }
                asm volatile("" ::: "memory"); }
    }
};
struct EpiOut {
    const float* X; bf16_t* H1; float sc;
    __device__ __forceinline__ void operator()(const f32x4 (&acc)[2][2][4][2], const Unit& u, int wr, int wc, int fr, int fq) const {
#pragma unroll
        for (int ai = 0; ai < 2; ++ai)
#pragma unroll
            for (int m = 0; m < 4; ++m) { const size_t ro = (size_t)(u.pm * 256 + ai * HALF + wr * 64 + m * 16 + fr) * D + u.pn * 256 + wc * 32 + 8 * fq;
#pragma unroll
                for (int bj = 0; bj < 2; ++bj) { const f32x4 x0 = *(const f32x4*)(X + ro + bj * HALF), x1 = *(const f32x4*)(X + ro + bj * HALF + 4);
                    const f32x4 v0 = x0 + acc[ai][bj][m][0] * sc, v1 = x1 + acc[ai][bj][m][1] * sc;
                    u32x4 w; w.x = cvt_pk_bf16(v0[0], v0[1]); w.y = cvt_pk_bf16(v0[2], v0[3]); w.z = cvt_pk_bf16(v1[0], v1[1]); w.w = cvt_pk_bf16(v1[2], v1[3]);
                    *(u32x4*)(H1 + ro + bj * HALF) = w; }
                asm volatile("" ::: "memory"); }
    }
};

__device__ __forceinline__ void moe_tables(Frame& F) {
    volatile LAS int* tb = (volatile LAS int*)(F.lds + MOE_TB_OFF); volatile LAS int* cnt = (volatile LAS int*)(F.lds + MOE_CNT_OFF);
    const int tid_ = F.wave * 64 + fresh_lane();
    __syncthreads();
    if (tid_ < NE) cnt[tid_] = (int)__hip_atomic_load(F.ctl + CW_CNT + 64 * tid_, __ATOMIC_RELAXED, __HIP_MEMORY_SCOPE_AGENT);
    __syncthreads();
    if (tid_ == 0) { int run = 0; for (int e = 0; e < NE; ++e) { tb[e] = run; run += (cnt[e] + 255) >> 8; } tb[NE] = run < MAXT ? run : MAXT; }
    __syncthreads();
}
struct MoeOrder {
    int G, c, nPN; const volatile LAS int* tb;
    __device__ bool next(int i, Unit& u) const {
        const int L = i * G + c, TT = tb[NE]; if (L >= TT * nPN) return false;
        const int t = L / nPN; u.pm = t; u.pn = L - t * nPN; int e = 0;
        for (int j = 1; j < NE; ++j) e += (tb[j] <= t) ? 1 : 0;
        u.ex = e; return true;
    }
};
struct MoeAB1 {
    const char* HB; const char* W1T; const int* lists; const volatile LAS int* tb; const volatile LAS int* cnt;
    __device__ __forceinline__ const char* a_base(const Unit&) const { return HB; }
    __device__ __forceinline__ const char* b_base(const Unit& u) const { return W1T + ((size_t)u.ex * 4096 + (size_t)u.pn * 256) * D; }
    __device__ __forceinline__ void a_voff(const Unit& u, const int (&R)[2], const int (&C)[2], unsigned (&v)[4]) const {
        const int base = (u.pm - tb[u.ex]) * 256, n = cnt[u.ex]; const int* le = lists + (size_t)u.ex * MAXL;
#pragma unroll
        for (int h = 0; h < 2; ++h)
#pragma unroll
            for (int i = 0; i < 2; ++i) { const int row = base + R[i] + HALF * h; const int tok = le[row < n ? row : 0]; v[2 * h + i] = (unsigned)(tok * D + 2 * C[i]); }
    }
};
struct MoeAB2 {
    const char* Gb; const char* W2T;
    __device__ __forceinline__ const char* a_base(const Unit& u) const { return Gb + (size_t)u.pm * 256 * DFF; }
    __device__ __forceinline__ const char* b_base(const Unit& u) const { return W2T + ((size_t)u.ex * D + (size_t)u.pn * 256) * DFF; }
    __device__ __forceinline__ void a_voff(const Unit&, const int (&R)[2], const int (&C)[2], unsigned (&v)[4]) const {
#pragma unroll
        for (int i = 0; i < 2; ++i) { v[i] = (unsigned)(R[i] * DFF + 2 * C[i]); v[2 + i] = (unsigned)((R[i] + HALF) * DFF + 2 * C[i]); } }
};
struct EpiMoe1 {
    const float* b1; unsigned char* G;
    __device__ __forceinline__ void operator()(const f32x4 (&acc)[2][2][4][2], const Unit& u, int wr, int wc, int fr, int fq) const {
        const int col0 = u.pn * 256 + wc * 32 + 8 * fq; const float* bp = b1 + (size_t)u.ex * 4096 + col0;
        const f32x4 ba0 = *(const f32x4*)(bp), ba1 = *(const f32x4*)(bp + 4), bb0 = *(const f32x4*)(bp + HALF), bb1 = *(const f32x4*)(bp + HALF + 4);
#pragma unroll
        for (int ai = 0; ai < 2; ++ai)
#pragma unroll
            for (int m = 0; m < 4; ++m) { unsigned char* rowp = G + (size_t)(u.pm * 256 + ai * HALF + wr * 64 + m * 16 + fr) * DFF + (col0 >> 1);
#pragma unroll
                for (int bj = 0; bj < 2; ++bj) { const f32x4 v0 = acc[ai][bj][m][0] * F8_WINV + (bj ? bb0 : ba0), v1 = acc[ai][bj][m][1] * F8_WINV + (bj ? bb1 : ba1);
                    float o[4];
                    const float ga[4] = {v0[0], v0[2], v1[0], v1[2]}, li[4] = {v0[1], v0[3], v1[1], v1[3]};
#pragma unroll
                    for (int j = 0; j < 4; ++j) { const float a = fminf(ga[j], 7.0f), l = fminf(fmaxf(li[j], -7.0f), 7.0f);
                        const float sg = __builtin_amdgcn_rcpf(1.0f + __builtin_amdgcn_exp2f(-1.702f * 1.4426950408889634f * a)); o[j] = (a * sg) * (l + 1.0f); }
                    *(unsigned*)(rowp + bj * (HALF / 2)) = cvt4_fp8(o[0], o[1], o[2], o[3]); }
                asm volatile("" ::: "memory"); }
    }
};
struct EpiMoe2 {
    const float* b2; bf16_t* Y;
    __device__ __forceinline__ void operator()(const f32x4 (&acc)[2][2][4][2], const Unit& u, int wr, int wc, int fr, int fq) const {
        const int col0 = u.pn * 256 + wc * 32 + 8 * fq; const float* bp = b2 + (size_t)u.ex * D + col0;
        const f32x4 ba0 = *(const f32x4*)(bp), ba1 = *(const f32x4*)(bp + 4), bb0 = *(const f32x4*)(bp + HALF), bb1 = *(const f32x4*)(bp + HALF + 4);
#pragma unroll
        for (int ai = 0; ai < 2; ++ai)
#pragma unroll
            for (int m = 0; m < 4; ++m) { bf16_t* rowp = Y + (size_t)(u.pm * 256 + ai * HALF + wr * 64 + m * 16 + fr) * D + col0;
#pragma unroll
                for (int bj = 0; bj < 2; ++bj) { const f32x4 v0 = acc[ai][bj][m][0] * F8_WINV + (bj ? bb0 : ba0), v1 = acc[ai][bj][m][1] * F8_WINV + (bj ? bb1 : ba1);
                    u32x4 w; w.x = cvt_pk_bf16(v0[0], v0[1]); w.y = cvt_pk_bf16(v0[2], v0[3]); w.z = cvt_pk_bf16(v1[0], v1[1]); w.w = cvt_pk_bf16(v1[2], v1[3]);
                    *(u32x4*)(rowp + bj * HALF) = w; }
                asm volatile("" ::: "memory"); }
    }
};

typedef float f32x4v __attribute__((ext_vector_type(4)));
__device__ __forceinline__ void router_phase(Frame& F) {
    const int gw = F.vcu * NWAVES + F.wave, NGW = F.G * NWAVES, lane = fresh_lane(), r = lane & 15, q = lane >> 4;
    const bf16_t* H1 = (const bf16_t*)(F.ws + WS_H1); bf16_t* HB = (bf16_t*)(F.ws + WS_HB);
    const bf16_t* wrh = (const bf16_t*)(F.ws + WS_WR); const bf16_t* wrl = wrh + NE * D;
    const float* g_ffn = F.in[12]; const float* b_router = F.in[14];
    float* GATE = (float*)(F.ws + WS_GATE); int* SEI = (int*)(F.ws + WS_SEI); int* LIST = (int*)(F.ws + WS_LIST);
    LAS float* lg = (LAS float*)(F.lds + RING_OFF + F.wave * 16384);
    for (int tile = (F.wave < 4 ? F.vcu * 4 + F.wave : NX), tstep = F.G * 4; tile < NX / 16; tile += tstep) {
        const int row = tile * 16 + r; const bf16_t* hp = H1 + (size_t)row * D + 8 * q;
        f32x4v c0 = {0.f, 0.f, 0.f, 0.f}, c1 = {0.f, 0.f, 0.f, 0.f}; float ss = 0.f;
#pragma unroll 2
        for (int s = 0; s < D / 32; ++s) {
            const u32x4 hw = *(const u32x4*)(hp + 32 * s);
            const float a0 = __uint_as_float(hw.x << 16), a1 = __uint_as_float(hw.x & 0xffff0000u), a2 = __uint_as_float(hw.y << 16), a3 = __uint_as_float(hw.y & 0xffff0000u);
            const float a4 = __uint_as_float(hw.z << 16), a5 = __uint_as_float(hw.z & 0xffff0000u), a6 = __uint_as_float(hw.w << 16), a7 = __uint_as_float(hw.w & 0xffff0000u);
            ss += (a0 * a0 + a1 * a1) + (a2 * a2 + a3 * a3) + (a4 * a4 + a5 * a5) + (a6 * a6 + a7 * a7);
            const bf16x8 ah = __builtin_bit_cast(bf16x8, hw);
            const size_t wo = (size_t)r * D + 32 * s + 8 * q;
            const bf16x8 bh0 = *(const bf16x8*)(wrh + wo), bl0 = *(const bf16x8*)(wrl + wo), bh1 = *(const bf16x8*)(wrh + wo + 16 * D), bl1 = *(const bf16x8*)(wrl + wo + 16 * D);
            c0 = __builtin_amdgcn_mfma_f32_16x16x32_bf16(ah, bh0, c0, 0, 0, 0); c0 = __builtin_amdgcn_mfma_f32_16x16x32_bf16(ah, bl0, c0, 0, 0, 0);
            c1 = __builtin_amdgcn_mfma_f32_16x16x32_bf16(ah, bh1, c1, 0, 0, 0); c1 = __builtin_amdgcn_mfma_f32_16x16x32_bf16(ah, bl1, c1, 0, 0, 0);
        }
        ss += __shfl_xor(ss, 16); ss += __shfl_xor(ss, 32);
        const float rs = 1.0f / sqrtf(ss * (1.0f / D) + EPS);
        {
            unsigned char* ob = (unsigned char*)HB + (size_t)row * D + 8 * q; const float* gp = g_ffn + 8 * q;
#pragma unroll 2
            for (int s = 0; s < D / 32; ++s) { const u32x4 hw = *(const u32x4*)(hp + 32 * s); const f32x4 g0 = *(const f32x4*)(gp + 32 * s), g1 = *(const f32x4*)(gp + 32 * s + 4);
                u32x2 w; w.x = cvt4_fp8(__uint_as_float(hw.x << 16) * rs * g0[0], __uint_as_float(hw.x & 0xffff0000u) * rs * g0[1], __uint_as_float(hw.y << 16) * rs * g0[2], __uint_as_float(hw.y & 0xffff0000u) * rs * g0[3]);
                w.y = cvt4_fp8(__uint_as_float(hw.z << 16) * rs * g1[0], __uint_as_float(hw.z & 0xffff0000u) * rs * g1[1], __uint_as_float(hw.w << 16) * rs * g1[2], __uint_as_float(hw.w & 0xffff0000u) * rs * g1[3]);
                *(u32x2*)(ob + 32 * s) = w; }
        }
#pragma unroll
        for (int i = 0; i < 4; ++i) { const float rsi = __shfl(rs, 4 * q + i); lg[(4 * q + i) * 33 + r] = c0[i] * rsi + b_router[r]; lg[(4 * q + i) * 33 + 16 + r] = c1[i] * rsi + b_router[16 + r]; }
        LDS_WAIT(); asm volatile("" ::: "memory");
        if (lane < 16) {
            const int trow = tile * 16 + lane; float l[NE];
#pragma unroll
            for (int e = 0; e < NE; ++e) l[e] = lg[lane * 33 + e];
            int i0 = -1, i1 = -1, i2 = -1, i3 = -1; float v0 = 0.f, v1 = 0.f, v2 = 0.f, v3 = 0.f;
#pragma unroll
            for (int k = 0; k < 4; ++k) { int bi = -1; float bv = 0.f;
#pragma unroll
                for (int e = 0; e < NE; ++e) { const bool used = (e == i0) || (e == i1) || (e == i2) || (e == i3); if (!used && (bi < 0 || l[e] > bv)) { bi = e; bv = l[e]; } }
                if (k == 0) { i0 = bi; v0 = bv; } else if (k == 1) { i1 = bi; v1 = bv; } else if (k == 2) { i2 = bi; v2 = bv; } else { i3 = bi; v3 = bv; } }
            const float p1 = __expf(v1 - v0), p2 = __expf(v2 - v0), p3 = __expf(v3 - v0), inv = 1.0f / (1.0f + p1 + p2 + p3);
            *(f32x4*)(GATE + (size_t)trow * 4) = (f32x4){inv, p1 * inv, p2 * inv, p3 * inv};
            const int o0 = (int)atomicAdd(F.ctl + CW_CNT + 64 * i0, 1u), o1 = (int)atomicAdd(F.ctl + CW_CNT + 64 * i1, 1u), o2 = (int)atomicAdd(F.ctl + CW_CNT + 64 * i2, 1u), o3 = (int)atomicAdd(F.ctl + CW_CNT + 64 * i3, 1u);
            LIST[(size_t)i0 * MAXL + o0] = trow; LIST[(size_t)i1 * MAXL + o1] = trow; LIST[(size_t)i2 * MAXL + o2] = trow; LIST[(size_t)i3 * MAXL + o3] = trow;
            typedef int i32x4 __attribute__((ext_vector_type(4)));
            *(i32x4*)(SEI + (size_t)trow * 4) = (i32x4){(i0 << 16) | o0, (i1 << 16) | o1, (i2 << 16) | o2, (i3 << 16) | o3};
        }
        LDS_WAIT(); asm volatile("" ::: "memory");
    }
}
__device__ __forceinline__ void final_phase(Frame& F) {
    const int lane_ = fresh_lane();
    const int gw = F.vcu * NWAVES + F.wave, NGW = F.G * NWAVES;
    const bf16_t* H1 = (const bf16_t*)(F.ws + WS_H1); const bf16_t* Y = (const bf16_t*)(F.ws + WS_Y); const float* GATE = (const float*)(F.ws + WS_GATE); const int* SEI = (const int*)(F.ws + WS_SEI);
    const float* g_fin = F.in[19]; volatile LAS int* tb = (volatile LAS int*)(F.lds + MOE_TB_OFF);
    for (int t = gw; t < NX; t += NGW) {
        const GAS u32x2* hr = (const GAS u32x2*)(H1 + (size_t)t * D) + lane_;
        f32x4 v[8];
#pragma unroll
        for (int j = 0; j < 8; ++j) { const u32x2 w = hr[64 * j]; v[j] = (f32x4){__uint_as_float(w.x << 16), __uint_as_float(w.x & 0xffff0000u), __uint_as_float(w.y << 16), __uint_as_float(w.y & 0xffff0000u)}; }
        const f32x4 gt = *(const f32x4*)(GATE + (size_t)t * 4);
        typedef int i32x4 __attribute__((ext_vector_type(4)));
        const i32x4 se = *(const i32x4*)(SEI + (size_t)t * 4);
#pragma unroll
        for (int k = 0; k < 4; ++k) { const int e = se[k] >> 16, i = se[k] & 0xffff; const size_t slot = (size_t)tb[e] * 256 + i; const float gk = gt[k];
            const GAS u32x2* yr = (const GAS u32x2*)(Y + slot * D) + lane_;
#pragma unroll
            for (int j = 0; j < 8; ++j) { const u32x2 w = yr[64 * j];
                v[j][0] += gk * __uint_as_float(w.x << 16); v[j][1] += gk * __uint_as_float(w.x & 0xffff0000u); v[j][2] += gk * __uint_as_float(w.y << 16); v[j][3] += gk * __uint_as_float(w.y & 0xffff0000u); } }
        float s = 0.f;
#pragma unroll
        for (int j = 0; j < 8; ++j) s += (v[j][0] * v[j][0] + v[j][1] * v[j][1]) + (v[j][2] * v[j][2] + v[j][3] * v[j][3]);
        float rs = 1.0f / sqrtf(wave_sum(s) * (1.0f / D) + EPS);
        GAS f32x4* orow = (GAS f32x4*)(F.out + (size_t)t * D) + lane_; const GAS f32x4* gr = (const GAS f32x4*)g_fin + lane_;
#pragma unroll
        for (int j = 0; j < 8; ++j) { const f32x4 g = gr[64 * j]; orow[64 * j] = v[j] * rs * g; }
    }
}

namespace at {
typedef float f32x16 __attribute__((ext_vector_type(16)));
typedef short s16x4 __attribute__((ext_vector_type(4)));
constexpr int NW = 8, QBLK = 32, KVBLK = 64, QB = NW * QBLK, HD = 128;
constexpr int SHM_V = KVBLK * HD * 2, SHM_K = KVBLK * HD * 2;
constexpr int ATT_LDS = 2 * SHM_V + 2 * SHM_K + NW * 64 * 4;
constexpr int LDQ = 1024, LDKV = 1024;
constexpr int NWM = 129;
constexpr float SCALE = 0.08838834764831845f, THR = 8.f;
#define KSWZ(row, colB) ((row) * 256 + ((colB) ^ (((row) & 7) << 4)))
#define SBAR() __builtin_amdgcn_sched_barrier(0)
__device__ __forceinline__ int v_st(int k, int c) { const int kk = (k & ~0xC) | ((k & 4) << 1) | ((k & 8) >> 1); return ((kk >> 3) * 4 + (c >> 5)) * 512 + ((kk & 7) * 32 + (c & 31)) * 2; }
__device__ __forceinline__ int v_rd_base(int lane) { return ((lane & 3) << 3) | (((lane >> 2) & 3) << 6) | (((lane >> 4) & 1) << 5) | (((lane >> 5) & 1) << 8); }
constexpr int v_rd_off(int d0, int ks, int half) { return d0 * 512 + ks * 4096 + half * 2048; }
__device__ __forceinline__ int crow(int r, int hi) { return (r & 3) + 8 * (r >> 2) + 4 * hi; }
__device__ __forceinline__ bf16x8 load8(const bf16_t* p) { return *reinterpret_cast<const bf16x8*>(p); }
__device__ __forceinline__ float xor1f(float v) { return __int_as_float(__builtin_amdgcn_update_dpp(0, __float_as_int(v), 0xB1, 0xF, 0xF, true)); }
__device__ __forceinline__ void mask_tile(f32x16& p0, f32x16& p1, int dq) {
    const float NEG = -__builtin_inff();
#pragma unroll
    for (int r = 0; r < 16; ++r) { const int c = (r & 3) + 8 * (r >> 2); if (dq - c < 0) p0[r] = NEG; if (dq - c - 32 < 0) p1[r] = NEG; }
}
__device__ __forceinline__ void mask_bits(f32x16& p0, f32x16& p1, unsigned long long w, int hi) {
    const unsigned long long wsft = w >> (4 * hi); const int lo = (int)(unsigned)wsft, hb = (int)(unsigned)(wsft >> 32); const int NEGB = (int)0xFF800000u;
#pragma unroll
    for (int r = 0; r < 16; ++r) { const int c = (r & 3) + 8 * (r >> 2);
        const int t0 = __builtin_amdgcn_sbfe(lo, c, 1), t1 = __builtin_amdgcn_sbfe(hb, c, 1);
        p0[r] = __int_as_float((__float_as_int(p0[r]) & t0) | (~t0 & NEGB)); p1[r] = __int_as_float((__float_as_int(p1[r]) & t1) | (~t1 & NEGB)); }
}
__device__ __forceinline__ void partialSM(f32x16& p0, f32x16& p1, float& m_reg, float& mn, float& alpha) {
    float pmax = p0[0];
#pragma unroll
    for (int r = 1; r < 16; ++r) pmax = fmaxf(pmax, p0[r]);
#pragma unroll
    for (int r = 0; r < 16; ++r) pmax = fmaxf(pmax, p1[r]);
    { auto rr = __builtin_amdgcn_permlane32_swap(__float_as_uint(pmax), __float_as_uint(pmax), false, false);
      pmax = fmaxf(__uint_as_float(rr[0]), __uint_as_float(rr[1])); }
    constexpr float C2 = 1.4426950408889634f * SCALE;
    if (__builtin_expect(__all((pmax - m_reg) * SCALE <= THR), 1)) { mn = m_reg; alpha = 1.f; }
    else { mn = fmaxf(m_reg, pmax); alpha = __builtin_amdgcn_exp2f((m_reg - mn) * C2); m_reg = mn; }
    const float mnL = -mn * C2;
#pragma unroll
    for (int r = 0; r < 16; ++r) p0[r] = fmaf(p0[r], C2, mnL);
#pragma unroll
    for (int r = 0; r < 16; ++r) p1[r] = fmaf(p1[r], C2, mnL);
#pragma unroll
    for (int r = 0; r < 16; ++r) p0[r] = __builtin_amdgcn_exp2f(p0[r]);
}
__device__ __forceinline__ void finishSM(f32x16& p0, f32x16& p1, float alpha, float& l_reg, bf16x8& pa0, bf16x8& pa1, bf16x8& pa2, bf16x8& pa3) {
#pragma unroll
    for (int r = 0; r < 16; ++r) p1[r] = __builtin_amdgcn_exp2f(p1[r]);
    float ps = 0;
#pragma unroll
    for (int r = 0; r < 16; ++r) ps += p0[r];
#pragma unroll
    for (int r = 0; r < 16; ++r) ps += p1[r];
    { auto rr = __builtin_amdgcn_permlane32_swap(__float_as_uint(ps), __float_as_uint(ps), false, false);
      ps = __uint_as_float(rr[0]) + __uint_as_float(rr[1]); }
    l_reg = l_reg * alpha + ps;
#define PK4(P, B_, OUT) do { unsigned a0 = cvt_pk_bf16(P[B_+0], P[B_+1]), a1 = cvt_pk_bf16(P[B_+2], P[B_+3]);                          \
        unsigned b0 = cvt_pk_bf16(P[B_+4], P[B_+5]), b1 = cvt_pk_bf16(P[B_+6], P[B_+7]);                                             \
        auto r0 = __builtin_amdgcn_permlane32_swap(a0, b0, false, false); auto r1 = __builtin_amdgcn_permlane32_swap(a1, b1, false, false); \
        u32x4 w = {r0[0], r1[0], r0[1], r1[1]}; OUT = *reinterpret_cast<bf16x8*>(&w); } while (0)
    PK4(p0, 0, pa0); PK4(p0, 8, pa1); PK4(p1, 0, pa2); PK4(p1, 8, pa3);
#undef PK4
}
template <int KB>
__device__ __forceinline__ void qkt(f32x16& p0, f32x16& p1, const LAS char* K_lds, int r32, int hi, const bf16x8* qr) {
    p0 = f32x16{}; p1 = f32x16{};
    const LAS char* kb[4];
#pragma unroll
    for (int dd = 0; dd < 4; ++dd) kb[dd] = K_lds + KB * SHM_K + KSWZ(r32, (dd * 16 + hi * 8) * 2);
#pragma unroll
    for (int d0 = 0; d0 < 8; ++d0) { const LAS char* a = kb[d0 & 3] + (d0 >> 2) * 128;
        bf16x8 b0 = *(const LAS bf16x8*)(a);
        bf16x8 b1 = *(const LAS bf16x8*)(a + 32 * 256);
        p0 = __builtin_amdgcn_mfma_f32_32x32x16_bf16(b0, qr[d0], p0, 0, 0, 0);
        p1 = __builtin_amdgcn_mfma_f32_32x32x16_bf16(b1, qr[d0], p1, 0, 0, 0); }
}
template <int VB>
__device__ __forceinline__ void pv_tile(f32x16* o, int vb0, bf16x8 pa0, bf16x8 pa1, bf16x8 pa2, bf16x8 pa3) {
#define TRRD(dst, off) asm volatile("ds_read_b64_tr_b16 %0, %1 offset:%2" : "=&v"(dst) : "v"(vb0), "i"(off) : "memory")
#define PV_D0(d0) do { s16x4 l0, l1, l2, l3, h0, h1, h2, h3; constexpr int b_ = VB * SHM_V + v_rd_off(d0, 0, 0); \
        TRRD(l0, b_); TRRD(h0, b_ + 2048); TRRD(l1, b_ + 4096); TRRD(h1, b_ + 6144); TRRD(l2, b_ + 8192); TRRD(h2, b_ + 10240); TRRD(l3, b_ + 12288); TRRD(h3, b_ + 14336); \
        asm volatile("s_waitcnt lgkmcnt(0)" ::: "memory"); SBAR();   \
        o[d0] = __builtin_amdgcn_mfma_f32_32x32x16_bf16(pa0, (bf16x8){l0[0], l0[1], l0[2], l0[3], h0[0], h0[1], h0[2], h0[3]}, o[d0], 0, 0, 0);   \
        o[d0] = __builtin_amdgcn_mfma_f32_32x32x16_bf16(pa1, (bf16x8){l1[0], l1[1], l1[2], l1[3], h1[0], h1[1], h1[2], h1[3]}, o[d0], 0, 0, 0);   \
        o[d0] = __builtin_amdgcn_mfma_f32_32x32x16_bf16(pa2, (bf16x8){l2[0], l2[1], l2[2], l2[3], h2[0], h2[1], h2[2], h2[3]}, o[d0], 0, 0, 0);   \
        o[d0] = __builtin_amdgcn_mfma_f32_32x32x16_bf16(pa3, (bf16x8){l3[0], l3[1], l3[2], l3[3], h3[0], h3[1], h3[2], h3[3]}, o[d0], 0, 0, 0); } while (0)
    PV_D0(0); PV_D0(1); PV_D0(2); PV_D0(3);
#undef PV_D0
#undef TRRD
}
constexpr int LDO = 3072;
struct BlockRef { unsigned q, k, v, o, m; int P0; };
struct Seam { bf16x8 qr[8]; bf16x8 st_v0, st_v1, st_k0, st_k1; };
#define VMW() asm volatile("s_waitcnt vmcnt(0)" ::: "memory")
#define VMWN(n) asm volatile("s_waitcnt vmcnt(%0)" :: "i"(n) : "memory")
#define SLOAD_H(Kp, Vp, k0) do { const bf16_t* kb_ = (Kp) + (size_t)(k0) * LDKV; const bf16_t* vb_ = (Vp) + (size_t)(k0) * LDKV;              \
                         const bf16_t* kb2_ = kb_ + 32 * LDKV; const bf16_t* vb2_ = vb_ + 32 * LDKV;                                           \
                         S.st_v0 = load8(vb_ + lo0); S.st_v1 = load8(vb2_ + lo0); S.st_k0 = load8(kb_ + lo0); S.st_k1 = load8(kb2_ + lo0); } while (0)
#define SWRITE_HK(bf) do { *(LAS bf16x8*)(K_lds + (bf) * SHM_K + kws) = S.st_k0; *(LAS bf16x8*)(K_lds + (bf) * SHM_K + kws + 32 * 256) = S.st_k1; } while (0)
#define SWRITE_HV(bf) do { *(LAS bf16x8*)(V_lds + (bf) * SHM_V + vst0) = S.st_v0; *(LAS bf16x8*)(V_lds + (bf) * SHM_V + vst0 + 8192) = S.st_v1; } while (0)
#define SWRITE_H(bf) do { SWRITE_HV(bf); SWRITE_HK(bf); } while (0)
#define QLOAD(ref) do { const bf16_t* qb_ = (const bf16_t*)(wsb + (ref).q); _Pragma("unroll") for (int d0 = 0; d0 < 8; ++d0) S.qr[d0] = load8(qb_ + qlo_off + d0 * 16); } while (0)
__device__ __forceinline__ void attn_prime(const unsigned char* wsb, const BlockRef& cur, LAS char* lds, Seam& S, int wave_) {
    const int wid = wave_, lane = fresh_lane(), tid = wid * 64 + lane, r32 = lane & 31, hi = lane >> 5;
    const int sr = tid >> 4, sc = (tid & 15) * 8, kws = KSWZ(sr, sc * 2); LAS char* K_lds = lds + 2 * SHM_V;
    const unsigned lo0 = (unsigned)(sr * LDKV + sc), qlo_off = (unsigned)((wid * QBLK + r32) * LDQ + hi * 8);
    QLOAD(cur);
    SLOAD_H((const bf16_t*)(wsb + cur.k), (const bf16_t*)(wsb + cur.v), 0); VMW(); SWRITE_HK(0);
    __syncthreads();
}
__device__ __forceinline__ void attn_block(const unsigned char* wsb, const BlockRef& cur, const BlockRef& nxt, int skv, LAS char* lds, Seam& S, int wave_) {
    const int wid = wave_, lane = fresh_lane(), tid = wid * 64 + lane, r32 = lane & 31, hi = lane >> 5;
    int j_hi = (cur.P0 + QB - 1) / KVBLK + 1; if (j_hi > skv / KVBLK) j_hi = skv / KVBLK;
    const int NT = j_hi;
    const int qlo = cur.P0 + wid * QBLK, qm = qlo + r32 - 4 * hi;
    LAS char* V_lds = lds; LAS char* K_lds = lds + 2 * SHM_V;
    LAS float* wsp = (LAS float*)(lds + 2 * SHM_V + 2 * SHM_K) + wid * 64; LAS float* li_l = wsp; LAS float* al_l = wsp + 32;
    float m_reg = -1e30f, l_reg = 0; f32x16 o[4] = {};
    const int sr = tid >> 4, sc = (tid & 15) * 8, vst0 = v_st(sr, sc), kws = KSWZ(sr, sc * 2);
    const unsigned lo0 = (unsigned)(sr * LDKV + sc), qlo_off = (unsigned)((wid * QBLK + r32) * LDQ + hi * 8);
    const int vb0 = (int)(unsigned)(uintptr_t)V_lds + v_rd_base(lane);
    const bf16_t* Kh = (const bf16_t*)(wsb + cur.k); const bf16_t* Vh = (const bf16_t*)(wsb + cur.v);
    const unsigned long long* Mb = (const unsigned long long*)(wsb + cur.m); const bool masked = cur.m != 0u; const unsigned moff = (unsigned)((wid * QBLK + r32) * NWM);
    unsigned long long mw = ~0ull;
#define MLOAD(t) do { mw = Mb[moff + (unsigned)(t)]; } while (0)
#define RESC(a) do { if (__any((a) < 1.f)) { if (hi == 0) al_l[r32] = (a); asm volatile("s_waitcnt lgkmcnt(0)" ::: "memory");              \
                     for (int d_ = 0; d_ < 4; ++d_) for (int r = 0; r < 16; ++r) o[d_][r] *= al_l[crow(r, hi)]; } } while (0)
#define KBASE(t) ((t) * KVBLK)
#define MASKT(P0_, P1_, t) do { mask_bits(P0_, P1_, mw, hi); } while (0)
    f32x16 pA0, pA1, pB0, pB1; float mnA, mnB, alA, alB; bf16x8 pa0, pa1, pa2, pa3;
    SWRITE_HV(0); SBAR();
    MLOAD(0);
    if (NT > 1) SLOAD_H(Kh, Vh, KBASE(1));
    SBAR(); qkt<0>(pA0, pA1, K_lds, r32, hi, S.qr);
    MASKT(pA0, pA1, 0); partialSM(pA0, pA1, m_reg, mnA, alA);
    if (NT > 1) { VMW(); SWRITE_H(1); }
    __syncthreads();
#define HALF_STEP(PX0, PX1, mnX, alX, PY0, PY1, alY, t, KB, VB, SB) do {                                                      \
        SBAR(); MLOAD(t); qkt<KB>(PX0, PX1, K_lds, r32, hi, S.qr);                                             \
        finishSM(PY0, PY1, alY, l_reg, pa0, pa1, pa2, pa3); SBAR();                                                           \
        if ((t) + 1 < NT) { SLOAD_H(Kh, Vh, KBASE((t) + 1)); SBAR(); }                                               \
        pv_tile<VB>(o, vb0, pa0, pa1, pa2, pa3); MASKT(PX0, PX1, (t)); partialSM(PX0, PX1, m_reg, mnX, alX);                                        \
        __syncthreads();                                                                                                      \
        if ((t) + 1 < NT) { VMW(); SWRITE_H(SB); }                                                                          \
        RESC(alX); __syncthreads(); } while (0)
    for (int t = 1; t + 1 < NT; t += 2) {
        HALF_STEP(pB0, pB1, mnB, alB, pA0, pA1, alA, t, 1, 0, 0);
        HALF_STEP(pA0, pA1, mnA, alA, pB0, pB1, alB, t + 1, 0, 1, 1);
    }
    const bool even = (NT & 1) == 0;
    if (even) { SBAR(); MLOAD(NT - 1); qkt<1>(pB0, pB1, K_lds, r32, hi, S.qr); SBAR(); }
    SLOAD_H((const bf16_t*)(wsb + nxt.k), (const bf16_t*)(wsb + nxt.v), 0); SBAR();
    QLOAD(nxt);
    SBAR();
    finishSM(pA0, pA1, alA, l_reg, pa0, pa1, pa2, pa3); SBAR();
    pv_tile<0>(o, vb0, pa0, pa1, pa2, pa3);
    if (even) { MASKT(pB0, pB1, NT - 1); partialSM(pB0, pB1, m_reg, mnB, alB); __syncthreads(); RESC(alB);
        finishSM(pB0, pB1, alB, l_reg, pa0, pa1, pa2, pa3); SBAR(); pv_tile<1>(o, vb0, pa0, pa1, pa2, pa3); }
    SBAR(); VMWN(8); SWRITE_HK(0); SBAR();
    if (hi == 0) li_l[r32] = l_reg; asm volatile("s_waitcnt lgkmcnt(0)" ::: "memory");
    float rli[16];
#pragma unroll
    for (int r = 0; r < 16; ++r) rli[r] = __builtin_amdgcn_rcpf(li_l[crow(r, hi)]);
    int hiE = hi, r32E = r32; asm volatile("" : "+v"(hiE), "+v"(r32E));
    unsigned char* Ow = (unsigned char*)(wsb + cur.o) + (unsigned)((wid * QBLK + 4 * hiE) * 2048 + r32E);
#pragma unroll
    for (int r = 0; r < 16; ++r) { const int orow = (r & 3) + 8 * (r >> 2);
#pragma unroll
        for (int d0 = 0; d0 < 4; ++d0) { const float v = o[d0][r] * (rli[r] * 16.0f);
            const float vn = xor1f(v);
            const int w = __builtin_amdgcn_cvt_pk_fp8_f32(v, vn, 0, false);
            const int w2 = __builtin_amdgcn_update_dpp(0, w, 0x4E, 0xF, 0xF, true);
            if ((r32 & 3) == 0) *(unsigned*)(Ow + orow * 2048 + d0 * 32) = ((unsigned)w & 0xffffu) | ((unsigned)w2 << 16); } }
    __syncthreads();
#undef MLOAD
#undef RESC
#undef KBASE
#undef MASKT
#undef HALF_STEP
}
#undef VMW
#undef VMWN
#undef SLOAD_H
#undef SWRITE_HK
#undef SWRITE_HV
#undef SWRITE_H
#undef QLOAD

struct CvCtx { const float* w1; const float* w2; const float* wua; const float* wub; const float* wo; unsigned char* ws; int stride; };
constexpr int CV_I1 = (D / 64) * (4096 / 32), CV_I2 = (DFF / 64) * (D / 32), CV_EXP = NE * (CV_I1 + CV_I2);
constexpr int CV_IU = (1024 / 64) * (D / 32), CV_IO = (D / 64) * (D / 32), CV_TOTAL = CV_EXP + 2 * CV_IU + CV_IO;
__device__ __forceinline__ void cv_decode(const CvCtx& c, int r, const float*& src, int& N, unsigned char*& dst) {
    if (r < NE * CV_I1) { const int e = r / CV_I1, w = r % CV_I1, kb = w >> 7, nb = w & 127;
        src = c.w1 + (size_t)e * D * 4096 + (size_t)(64 * kb) * 4096 + 32 * nb; N = 4096; dst = c.ws + WS_W1 + (size_t)e * 4096 * D + (size_t)(32 * nb) * D + 64 * kb; }
    else if (r < CV_EXP) { const int q = r - NE * CV_I1, e = q / CV_I2, w = q % CV_I2, kb = w >> 6, nb = w & 63;
        src = c.w2 + (size_t)e * DFF * D + (size_t)(64 * kb) * D + 32 * nb; N = D; dst = c.ws + WS_W2 + (size_t)e * D * DFF + (size_t)(32 * nb) * DFF + 64 * kb; }
    else { int q = r - CV_EXP; N = D;
        if (q < 2 * CV_IU) { const int second = q >= CV_IU; if (second) q -= CV_IU; const int kb = q >> 6, nb = q & 63;
            src = (second ? c.wub : c.wua) + (size_t)(64 * kb) * D + 32 * nb; dst = c.ws + WS_WUPA + (size_t)(32 * nb) * 2048 + 1024 * second + 64 * kb; }
        else { q -= 2 * CV_IU; const int kb = q >> 6, nb = q & 63; src = c.wo + (size_t)(64 * kb) * D + 32 * nb; dst = c.ws + WS_WOUT + (size_t)(32 * nb) * 2048 + 64 * kb; } }
}
__device__ __forceinline__ unsigned char* cv_load(const CvCtx& c, int r, int lane, f32x4 (&t)[8]) {
    const float* src; int N; unsigned char* dst; cv_decode(c, r, src, N, dst);
    const float* wp = src + (size_t)(lane >> 3) * N + 4 * (lane & 7);
#pragma unroll
    for (int i = 0; i < 8; ++i) t[i] = __builtin_nontemporal_load((const f32x4*)(wp + (size_t)(8 * i) * N));
    return dst;
}
__device__ __forceinline__ void cv_emit(unsigned char* dst, int lane, const f32x4 (&t)[8], LAS unsigned* scr) {
    { const int lr = lane >> 3, c4 = lane & 7;
#pragma unroll
      for (int i = 0; i < 8; ++i) { const f32x4 v = t[i] * F8_WSCALE; scr[(8 * i + lr) * 9 + c4] = cvt4_fp8(v[0], v[1], v[2], v[3]); } }
    LDS_WAIT(); asm volatile("" ::: "memory");
    const int cc = lane & 7, nq = lane >> 5, sh = (lane >> 3) & 3;
    const unsigned selA = (unsigned)sh | ((4u + (unsigned)sh) << 8);
#pragma unroll
    for (int j = 0; j < 4; ++j) { const LAS unsigned* p = scr + (8 * cc) * 9 + nq + 2 * j;
        const unsigned d0 = p[0], d1 = p[9], d2 = p[18], d3 = p[27], d4 = p[36], d5 = p[45], d6 = p[54], d7 = p[63];
        const unsigned p01 = __builtin_amdgcn_perm(d1, d0, selA), p23 = __builtin_amdgcn_perm(d3, d2, selA), p45 = __builtin_amdgcn_perm(d5, d4, selA), p67 = __builtin_amdgcn_perm(d7, d6, selA);
        u32x2 o; o.x = __builtin_amdgcn_perm(p23, p01, 0x05040100u); o.y = __builtin_amdgcn_perm(p67, p45, 0x05040100u);
        const int n = (lane >> 3) + 8 * j;
        __builtin_nontemporal_store(o, (u32x2*)(dst + (size_t)n * 2048 + 8 * cc)); }
    LDS_WAIT(); asm volatile("" ::: "memory");
}
__device__ __forceinline__ void cv_stash(const f32x4 (&t)[8], int lane, LAS unsigned* scr) {
    const int lr = lane >> 3, c4 = lane & 7;
#pragma unroll
    for (int i = 0; i < 8; ++i) { const f32x4 v = t[i] * F8_WSCALE; scr[(8 * i + lr) * 9 + c4] = cvt4_fp8(v[0], v[1], v[2], v[3]); }
}
__device__ __forceinline__ void cv_gather(const LAS unsigned* scr, int lane, int j, unsigned (&g)[8]) {
    const LAS unsigned* p = scr + (8 * (lane & 7)) * 9 + (lane >> 5) + 2 * j;
#pragma unroll
    for (int e = 0; e < 8; ++e) g[e] = p[9 * e];
}
__device__ __forceinline__ void cv_finish(unsigned char* dst, int lane, int j, const unsigned (&g)[8]) {
    const int cc = lane & 7, sh = (lane >> 3) & 3, n = (lane >> 3) + 8 * j; const unsigned selA = (unsigned)sh | ((4u + (unsigned)sh) << 8);
    const unsigned p01 = __builtin_amdgcn_perm(g[1], g[0], selA), p23 = __builtin_amdgcn_perm(g[3], g[2], selA), p45 = __builtin_amdgcn_perm(g[5], g[4], selA), p67 = __builtin_amdgcn_perm(g[7], g[6], selA);
    u32x2 o; o.x = __builtin_amdgcn_perm(p23, p01, 0x05040100u); o.y = __builtin_amdgcn_perm(p67, p45, 0x05040100u);
    __builtin_nontemporal_store(o, (u32x2*)(dst + (size_t)n * 2048 + 8 * cc));
}
template <int VB, int G>
__device__ __forceinline__ void pv_group(f32x16* o, int vb0, bf16x8 pa0, bf16x8 pa1, bf16x8 pa2, bf16x8 pa3) {
#define TRRD(dst, off) asm volatile("ds_read_b64_tr_b16 %0, %1 offset:%2" : "=&v"(dst) : "v"(vb0), "i"(off) : "memory")
    s16x4 l0, l1, l2, l3, h0, h1, h2, h3; constexpr int b_ = VB * SHM_V + v_rd_off(G, 0, 0);
    TRRD(l0, b_); TRRD(h0, b_ + 2048); TRRD(l1, b_ + 4096); TRRD(h1, b_ + 6144); TRRD(l2, b_ + 8192); TRRD(h2, b_ + 10240); TRRD(l3, b_ + 12288); TRRD(h3, b_ + 14336);
    asm volatile("s_waitcnt lgkmcnt(0)" ::: "memory"); SBAR();
    o[G] = __builtin_amdgcn_mfma_f32_32x32x16_bf16(pa0, (bf16x8){l0[0], l0[1], l0[2], l0[3], h0[0], h0[1], h0[2], h0[3]}, o[G], 0, 0, 0);
    o[G] = __builtin_amdgcn_mfma_f32_32x32x16_bf16(pa1, (bf16x8){l1[0], l1[1], l1[2], l1[3], h1[0], h1[1], h1[2], h1[3]}, o[G], 0, 0, 0);
    o[G] = __builtin_amdgcn_mfma_f32_32x32x16_bf16(pa2, (bf16x8){l2[0], l2[1], l2[2], l2[3], h2[0], h2[1], h2[2], h2[3]}, o[G], 0, 0, 0);
    o[G] = __builtin_amdgcn_mfma_f32_32x32x16_bf16(pa3, (bf16x8){l3[0], l3[1], l3[2], l3[3], h3[0], h3[1], h3[2], h3[3]}, o[G], 0, 0, 0);
    SBAR();
#undef TRRD
}
constexpr int CV_SCR0 = 139264, CV_SCRB = 2304;

struct PairRef { unsigned q, k, v, o; int P0; };
constexpr int PB_VLO = 0, PB_VHI = 32768, PB_K = 65536, PB_P = 98304, PB_SM = 135168;
__device__ __forceinline__ void attn_pair_block(const unsigned char* wsb, const PairRef& cur, int skv, LAS char* lds, int wave_, const CvCtx& cv, int& cvr) {
    const int wid = wave_, lane = fresh_lane(), r32 = lane & 31, hi = lane >> 5;
    const bool lead = wid < 4; const int w = wid & 3, tl = w * 64 + lane;
    int j_hi = (cur.P0 + 127) / KVBLK + 1; if (j_hi > skv / KVBLK) j_hi = skv / KVBLK;
    const int NT = j_hi;
    const int qlo = cur.P0 + w * QBLK, qm = qlo + r32 - 4 * hi;
    LAS char* Vlo = lds + PB_VLO; LAS char* Vhi = lds + PB_VHI; LAS char* K_lds = lds + PB_K;
    LAS char* Pb = lds + PB_P + w * 4096 + lane * 64;
    LAS float* li_l = (LAS float*)(lds + PB_SM + w * 1024); LAS float* al_l = li_l + 32; LAS int* afl = (LAS int*)(li_l + 160);
    const int sr = tl >> 4, sc = (tl & 15) * 8;
    const unsigned lo0 = (unsigned)(sr * LDKV + sc);
    const int vst0 = v_st(sr, sc), kws0 = KSWZ(sr, sc * 2);
    const int vb_lo = (int)(unsigned)(uintptr_t)Vlo + v_rd_base(lane), vb_hi = (int)(unsigned)(uintptr_t)Vhi + v_rd_base(lane);
    const bf16_t* Kh = (const bf16_t*)(wsb + cur.k); const bf16_t* Vh = (const bf16_t*)(wsb + cur.v);
#define LD4(dst, base) do { const bf16_t* b_ = (base); dst[0] = load8(b_ + lo0); dst[1] = load8(b_ + 16 * LDKV + lo0); dst[2] = load8(b_ + 32 * LDKV + lo0); dst[3] = load8(b_ + 48 * LDKV + lo0); } while (0)
#define ST4(ptr, src) do { _Pragma("unroll") for (int i_ = 0; i_ < 4; ++i_) *(LAS bf16x8*)((ptr) + 4096 * i_) = src[i_]; } while (0)
#define VMW() asm volatile("s_waitcnt vmcnt(0)" ::: "memory")
#define LGW() asm volatile("s_waitcnt lgkmcnt(0)" ::: "memory")
#define EPILOGUE(colofs) do { float rli[16];                                                                                                         \
        _Pragma("unroll") for (int r = 0; r < 16; ++r) rli[r] = __builtin_amdgcn_rcpf(li_l[crow(r, hi)]);                                            \
        int hiE = hi, r32E = r32; asm volatile("" : "+v"(hiE), "+v"(r32E));                                                                          \
        bf16_t* Ow = (bf16_t*)(wsb + cur.o) + (unsigned)((w * QBLK + 4 * hiE) * LDO + r32E) + (colofs);                                              \
        _Pragma("unroll") for (int r = 0; r < 16; ++r) { const int orow = (r & 3) + 8 * (r >> 2);                                                    \
            _Pragma("unroll") for (int d0 = 0; d0 < 4; ++d0) { const float v = o[d0][r] * rli[r]; const float vn = xor1f(v);                         \
                if ((r32 & 1) == 0) *(unsigned*)(Ow + orow * LDO + d0 * 32) = cvt_pk_bf16(v, vn); } } } while (0)
    if (lead) {
        f32x16 o[4] = {}; float m_reg = -1e30f, l_reg = 0.f;
        bf16x8 qr[8], stA[4]; f32x16 pA0, pA1, pB0, pB1; float mnA, mnB, alA, alB; bf16x8 pa0, pa1, pa2, pa3;
        { const bf16_t* qb_ = (const bf16_t*)(wsb + cur.q) + (unsigned)((w * QBLK + r32) * LDQ + hi * 8);
#pragma unroll
          for (int d0 = 0; d0 < 8; ++d0) qr[d0] = load8(qb_ + d0 * 16); }
        LD4(stA, Vh); VMW(); ST4(Vlo + vst0, stA);
        LGW(); __syncthreads();
        qkt<0>(pA0, pA1, K_lds, r32, hi, qr);
        if (KVBLK - 1 > qlo) { asm volatile("" ::: "memory"); mask_tile(pA0, pA1, qm); }
        partialSM(pA0, pA1, m_reg, mnA, alA);
        if (lane == 0) afl[0] = 0;
        LGW(); __syncthreads();
#define LFULL(s_, PAR, PX0, PX1, mnX, alX, PY0, PY1, alY) do { const int s = (s_);                                                                    \
            SBAR(); qkt<(PAR) ^ 1>(PX0, PX1, K_lds, r32, hi, qr);                                                                                    \
            finishSM(PY0, PY1, alY, l_reg, pa0, pa1, pa2, pa3); SBAR();                                                                              \
            { LAS char* pw_ = Pb + (PAR) * 16384; *(LAS bf16x8*)(pw_) = pa0; *(LAS bf16x8*)(pw_ + 16) = pa1; *(LAS bf16x8*)(pw_ + 32) = pa2; *(LAS bf16x8*)(pw_ + 48) = pa3; } \
            LD4(stA, Vh + (size_t)((s + 1) * KVBLK) * LDKV); SBAR();                                                                                 \
            pv_tile<PAR>(o, vb_lo, pa0, pa1, pa2, pa3);                                                                                              \
            { const int kb_ = (s + 1) * KVBLK; if (kb_ + KVBLK - 1 > qlo) { asm volatile("" ::: "memory"); mask_tile(PX0, PX1, qm - kb_); } }                                           \
            partialSM(PX0, PX1, m_reg, mnX, alX);                                                                                                    \
            VMW(); ST4(Vlo + ((PAR) ^ 1) * SHM_V + vst0, stA);                                                                                       \
            { const bool rs_ = __any((alX) < 1.f); const int sl_ = (s + 1) & 3; if (lane == 0) afl[sl_] = rs_ ? 1 : 0;                               \
              if (rs_) { if (hi == 0) al_l[sl_ * 32 + r32] = (alX); LGW();                                                                           \
                  _Pragma("unroll") for (int d_ = 0; d_ < 4; ++d_) _Pragma("unroll") for (int r = 0; r < 16; ++r) o[d_][r] *= al_l[sl_ * 32 + crow(r, hi)]; } } \
            LGW(); __syncthreads(); } while (0)
#define LLAST(PAR, PY0, PY1, alY) do {                                                                                                               \
            finishSM(PY0, PY1, alY, l_reg, pa0, pa1, pa2, pa3); SBAR();                                                                              \
            { LAS char* pw_ = Pb + (PAR) * 16384; *(LAS bf16x8*)(pw_) = pa0; *(LAS bf16x8*)(pw_ + 16) = pa1; *(LAS bf16x8*)(pw_ + 32) = pa2; *(LAS bf16x8*)(pw_ + 48) = pa3; } \
            pv_tile<PAR>(o, vb_lo, pa0, pa1, pa2, pa3);                                                                                              \
            LGW(); __syncthreads(); } while (0)
        int s2 = 0;
#pragma unroll 1
        for (; s2 + 2 <= NT - 1; s2 += 2) {
            LFULL(s2, 0, pB0, pB1, mnB, alB, pA0, pA1, alA);
            LFULL(s2 + 1, 1, pA0, pA1, mnA, alA, pB0, pB1, alB);
        }
        if (s2 < NT - 1) { LFULL(s2, 0, pB0, pB1, mnB, alB, pA0, pA1, alA); LLAST(1, pB0, pB1, alB); }
        else { LLAST(0, pA0, pA1, alA); }
#undef LFULL
#undef LLAST
        if (hi == 0) li_l[r32] = l_reg;
        LGW(); __syncthreads();
        EPILOGUE(0);
        __syncthreads();
    } else {
        f32x16 o[4] = {}; bf16x8 stA[4], stB[4]; bf16x8 pa0, pa1, pa2, pa3;
        f32x4 cvtA[8], cvtB[8]; unsigned char* cvpA = nullptr; unsigned char* cvpB = nullptr;
        LAS unsigned* cvscr = (LAS unsigned*)(lds + CV_SCR0 + w * CV_SCRB);
        LD4(stA, Kh); VMW(); ST4(K_lds + kws0, stA);
        LGW(); __syncthreads();
        LD4(stA, Kh + (size_t)KVBLK * LDKV); VMW(); ST4(K_lds + SHM_K + kws0, stA);
        LGW(); __syncthreads();
#define FSTEP(s_, PAR, CT, CP) do { const int s = (s_);                                            \
            unsigned char* const dst_ = (CP); const bool em_ = dst_ != nullptr && s >= 1; unsigned g_[8];                                             \
            if (dst_ != nullptr && !em_) cv_emit(dst_, lane, CT, cvscr);                                               \
            if (em_) cv_stash(CT, lane, cvscr);                                                         \
            (CP) = nullptr;                                                                                                                          \
            if (s < NT) LD4(stB, Vh + 128 + (size_t)(s * KVBLK) * LDKV);                                                                             \
            if (s + 2 < NT) LD4(stA, Kh + (size_t)((s + 2) * KVBLK) * LDKV);                                                                         \
            if (cvr < CV_TOTAL && (s & 3) != 3) { (CP) = cv_load(cv, cvr, lane, CT); cvr += cv.stride; }     \
            if (s >= 1) { const LAS char* pr_ = Pb + ((PAR) ^ 1) * 16384;                                                                            \
                pa0 = *(const LAS bf16x8*)(pr_); pa1 = *(const LAS bf16x8*)(pr_ + 16); pa2 = *(const LAS bf16x8*)(pr_ + 32); pa3 = *(const LAS bf16x8*)(pr_ + 48); \
                const int sl_ = (s - 1) & 3;                                                                                                         \
                if (afl[sl_]) { _Pragma("unroll") for (int d_ = 0; d_ < 4; ++d_) _Pragma("unroll") for (int r = 0; r < 16; ++r) o[d_][r] *= al_l[sl_ * 32 + crow(r, hi)]; } \
                pv_group<(PAR) ^ 1, 0>(o, vb_hi, pa0, pa1, pa2, pa3);                                                                                \
                if (em_) cv_gather(cvscr, lane, 0, g_);                                                 \
                pv_group<(PAR) ^ 1, 1>(o, vb_hi, pa0, pa1, pa2, pa3);                                                                                \
                if (em_) { cv_finish(dst_, lane, 0, g_); cv_gather(cvscr, lane, 1, g_); }                                                            \
                pv_group<(PAR) ^ 1, 2>(o, vb_hi, pa0, pa1, pa2, pa3);                                                                                \
                if (em_) { cv_finish(dst_, lane, 1, g_); cv_gather(cvscr, lane, 2, g_); }                                                            \
                pv_group<(PAR) ^ 1, 3>(o, vb_hi, pa0, pa1, pa2, pa3);                                                                                \
                if (em_) { cv_finish(dst_, lane, 2, g_); cv_gather(cvscr, lane, 3, g_); } }                                                          \
            if (s < NT) ST4(Vhi + (PAR) * SHM_V + vst0, stB);                                                                                        \
            if (s + 2 < NT) ST4(K_lds + (PAR) * SHM_K + kws0, stA);                                                                                  \
            LGW(); if (em_) cv_finish(dst_, lane, 3, g_);                                                                                            \
            __syncthreads(); } while (0)
#pragma unroll 1
        for (int s2 = 0; s2 <= NT; s2 += 2) {
            FSTEP(s2, 0, cvtA, cvpA);
            if (s2 + 1 <= NT) FSTEP(s2 + 1, 1, cvtB, cvpB);
        }
#undef FSTEP
        if (cvpA) cv_emit(cvpA, lane, cvtA, cvscr);
        if (cvpB) cv_emit(cvpB, lane, cvtB, cvscr);
        EPILOGUE(128);
        __syncthreads();
    }
#undef EPILOGUE
#undef LD4
#undef ST4
#undef VMW
#undef LGW
}
}

__device__ __forceinline__ at::BlockRef attn_ref(int bv, int qb) {
    const int b = bv / 24, vh = bv - b * 24; const unsigned row = (unsigned)(b * SEQ + qb * 256);
    at::BlockRef r; r.P0 = NMETA + qb * 256;
    if (vh < 8) { const unsigned h = (unsigned)vh;
        r.q = (unsigned)WS_QA + (row * 1024u + h * 128u) * 2u; r.k = (unsigned)WS_KA + ((unsigned)(b * TP) * 1024u + h * 128u) * 2u; r.v = (unsigned)WS_VA + ((unsigned)(b * TP) * 1024u + h * 128u) * 2u;
        r.o = (unsigned)WS_OA8 + row * 2048u + h * 128u; r.m = (unsigned)WS_MASK + row * (unsigned)at::NWM * 8u; }
    else { const unsigned j = (unsigned)(vh - 8), h = j >> 2, br = (j >> 1) & 1u, hf = j & 1u;
        r.q = (unsigned)WS_QB + (row * 1024u + h * 256u + br * 128u) * 2u; r.k = (unsigned)WS_KB + ((unsigned)(b * TP) * 1024u + h * 256u + br * 128u) * 2u; r.v = (unsigned)WS_VB + ((unsigned)(b * TP) * 1024u + h * 256u + hf * 128u) * 2u;
        r.o = (unsigned)WS_OALL + (row * (unsigned)at::LDO + 1024u + h * 512u + br * 256u + hf * 128u) * 2u; r.m = 0u; }
    return r;
}
__device__ __forceinline__ void attn_item(int L, int& bv, int& qb0, int& qb1) { const int xcd = L & 7, slot = (L >> 3) & 31, rnd = L >> 8; bv = rnd * 16 + xcd * 2 + (slot >> 4); const int pair = slot & 15; qb0 = pair; qb1 = 31 - pair; }
__device__ __forceinline__ void attn_phase(Frame& F) {
    constexpr int TOTAL = 768; const int stride = F.G;
    LAS char* lds = (LAS char*)(F.lds + RING_OFF);
    const unsigned char* wsb = F.ws;
    const at::CvCtx cv{F.in[15], F.in[17], F.in[9], F.in[10], F.in[11], F.ws, 4 * F.G};
    int cvr = (int)blockIdx.x * 4 + (F.wave & 3);
    for (int L = (int)blockIdx.x; L < TOTAL; L += stride) {
        const int xcd = L & 7, slot = (L >> 3) & 31, rnd = L >> 8; const int bv = rnd * 16 + xcd * 2 + (slot >> 4), pr = slot & 15;
        const int b = bv / 24, vh = bv - b * 24;
        if (vh < 8) {
            at::BlockRef cur = attn_ref(bv, pr); const at::BlockRef nxt = attn_ref(bv, 31 - pr);
            at::Seam S;
            at::attn_prime(wsb, cur, lds, S, F.wave);
            at::attn_block(wsb, cur, nxt, TP, lds, S, F.wave);
            at::attn_block(wsb, nxt, nxt, TP, lds, S, F.wave);
            __syncthreads();
        } else {
            const unsigned j = (unsigned)(vh - 8), h = j >> 2, br = (j >> 1) & 1u, hf = j & 1u; const int p = 16 * (int)hf + pr;
#pragma unroll 1
            for (int pass = 0; pass < 2; ++pass) {
                const int qb = pass ? 63 - p : p; const unsigned row = (unsigned)(b * SEQ + qb * 128);
                at::PairRef r; r.P0 = NMETA + qb * 128;
                r.q = (unsigned)WS_QB + (row * 1024u + h * 256u + br * 128u) * 2u; r.k = (unsigned)WS_KB + ((unsigned)(b * TP) * 1024u + h * 256u + br * 128u) * 2u;
                r.v = (unsigned)WS_VB + ((unsigned)(b * TP) * 1024u + h * 256u) * 2u; r.o = (unsigned)WS_OALL + (row * (unsigned)at::LDO + 1024u + h * 512u + br * 256u) * 2u;
                at::attn_pair_block(wsb, r, TP, lds, F.wave, cv, cvr);
            }
        }
    }
    {
        LAS int* cvsh = (LAS int*)(lds + at::CV_SCR0); const int lane = fresh_lane();
        __syncthreads();
        if (F.wave >= 4 && lane == 0) cvsh[F.wave - 4] = cvr;
        __syncthreads();
        int r = cvsh[F.wave & 3] + (F.wave >> 2) * cv.stride;
        __syncthreads();
        LAS unsigned* scr = (LAS unsigned*)(F.lds + RING_OFF + F.wave * 16384);
        for (; r < at::CV_TOTAL; r += 2 * cv.stride) { f32x4 t[8]; unsigned char* d = at::cv_load(cv, r, lane, t); at::cv_emit(d, lane, t, scr); }
    }
}
__device__ __forceinline__ void diff_phase(Frame& F) {
    const int gw = F.vcu * NWAVES + F.wave, NGW = F.G * NWAVES, lane = fresh_lane();
    const float* lq1 = F.in[4]; const float* lk1 = F.in[5]; const float* lq2 = F.in[6]; const float* lk2 = F.in[7]; const float* sg = F.in[8];
    const float s1 = wave_sum(lq1[lane] * lk1[lane] + lq1[lane + 64] * lk1[lane + 64]), s2 = wave_sum(lq2[lane] * lk2[lane] + lq2[lane + 64] * lk2[lane + 64]);
    const float lam = __expf(s1) - __expf(s2) + 0.2f;
    const f32x4 g4 = *(const f32x4*)(sg + 4 * lane);
    const bf16_t* OBR = (const bf16_t*)(F.ws + WS_OALL) + 1024; unsigned char* OB8 = F.ws + WS_OA8 + 1024;
    for (int r = gw; r < NX; r += NGW) {
#pragma unroll
        for (int h = 0; h < 4; ++h) {
            const u32x2 a = *(const u32x2*)(OBR + (size_t)r * at::LDO + h * 512 + 4 * lane), c = *(const u32x2*)(OBR + (size_t)r * at::LDO + h * 512 + 256 + 4 * lane);
            f32x4 d;
            d[0] = __uint_as_float(a.x << 16) - lam * __uint_as_float(c.x << 16); d[1] = __uint_as_float(a.x & 0xffff0000u) - lam * __uint_as_float(c.x & 0xffff0000u);
            d[2] = __uint_as_float(a.y << 16) - lam * __uint_as_float(c.y << 16); d[3] = __uint_as_float(a.y & 0xffff0000u) - lam * __uint_as_float(c.y & 0xffff0000u);
            const float ss = wave_sum((d[0] * d[0] + d[1] * d[1]) + (d[2] * d[2] + d[3] * d[3]));
            const float rs = 0.8f / sqrtf(ss * (1.0f / 256.0f) + EPS);
            *(unsigned*)(OB8 + (size_t)r * D + h * 256 + 4 * lane) = cvt4_fp8(d[0] * rs * g4[0], d[1] * rs * g4[1], d[2] * rs * g4[2], d[3] * rs * g4[3]);
        }
    }
}
typedef float f32x16i __attribute__((ext_vector_type(16)));
constexpr int IDX_ROWB = 144, IDX_CHUNK = 128, IDX_BUF = IDX_CHUNK * IDX_ROWB;
__device__ __forceinline__ void idx_phase(Frame& F) {
    const int lane = fresh_lane(), wave = F.wave, tid = wave * 64 + lane, n = lane & 31, hh = lane >> 5;
    const bf16_t* QI = (const bf16_t*)(F.ws + WS_QI); const bf16_t* KI = (const bf16_t*)(F.ws + WS_KI); const float* WI = (const float*)(F.ws + WS_WI); float* SC = (float*)(F.ws + WS_SC);
    LAS unsigned char* buf = F.lds + RING_OFF;
    for (int L = (int)blockIdx.x; L < 512; L += F.G) {
        const int b = (L >> 7) & 1, j = L & 127, hu = (L >> 8) ? 255 - j : j;
        const int P = NMETA + hu * 32;
        const int r0 = b * SEQ + hu * 32 + wave * 4;
        const int qq = (lane >> 2) & 1, hA = (lane & 3) + 4 * (n >> 3);
        bf16x8 afr[2][4]; float wv[2][16];
#pragma unroll
        for (int p = 0; p < 2; ++p) {
            const bf16_t* qp = QI + (size_t)(r0 + 2 * p + qq) * 1024 + hA * 64 + 8 * hh;
#pragma unroll
            for (int s = 0; s < 4; ++s) afr[p][s] = *(const bf16x8*)(qp + 16 * s);
            const float* wp = WI + (size_t)(r0 + 2 * p + hh) * 16;
#pragma unroll
            for (int h4 = 0; h4 < 4; ++h4) { const f32x4 t = *(const f32x4*)(wp + 4 * h4); wv[p][4 * h4] = t[0]; wv[p][4 * h4 + 1] = t[1]; wv[p][4 * h4 + 2] = t[2]; wv[p][4 * h4 + 3] = t[3]; }
        }
        const int lastpos = P + 31, nch = lastpos / IDX_CHUNK + 1;
        const bf16_t* kbase = KI + (size_t)b * TP * 64;
        const int k0i = tid >> 3, c16 = tid & 7;
        u32x4 st0, st1;
        __syncthreads();
        st0 = *(const u32x4*)(kbase + (size_t)(k0i) * 64 + c16 * 8); st1 = *(const u32x4*)(kbase + (size_t)(k0i + 64) * 64 + c16 * 8);
        *(LAS u32x4*)(buf + k0i * IDX_ROWB + c16 * 16) = st0; *(LAS u32x4*)(buf + (k0i + 64) * IDX_ROWB + c16 * 16) = st1;
        __syncthreads();
        for (int c = 0; c < nch; ++c) {
            const bool more = c + 1 < nch;
            if (more) { const bf16_t* kp = kbase + (size_t)((c + 1) * IDX_CHUNK) * 64;
                st0 = *(const u32x4*)(kp + (size_t)(k0i) * 64 + c16 * 8); st1 = *(const u32x4*)(kp + (size_t)(k0i + 64) * 64 + c16 * 8); }
            LAS unsigned char* cb = buf + (c & 1) * IDX_BUF;
#pragma unroll
            for (int sub = 0; sub < 4; ++sub) {
                const int key0 = c * IDX_CHUNK + sub * 32;
                if (key0 <= lastpos) {
                    bf16x8 bfr[4];
#pragma unroll
                    for (int s = 0; s < 4; ++s) bfr[s] = *(const LAS bf16x8*)(cb + (sub * 32 + n) * IDX_ROWB + (16 * s + 8 * hh) * 2);
#pragma unroll
                    for (int p = 0; p < 2; ++p) {
                        f32x16i acc = {};
#pragma unroll
                        for (int s = 0; s < 4; ++s) acc = __builtin_amdgcn_mfma_f32_32x32x16_bf16(afr[p][s], bfr[s], acc, 0, 0, 0);
                        float sc = 0.f;
#pragma unroll
                        for (int h = 0; h < 16; ++h) sc = fmaf(wv[p][h], fmaxf(acc[h], 0.f), sc);
                        SC[(size_t)(r0 + 2 * p + hh) * TP + key0 + n] = sc;
                    }
                }
            }
            if (more) { LAS unsigned char* nb = buf + ((c + 1) & 1) * IDX_BUF;
                *(LAS u32x4*)(nb + k0i * IDX_ROWB + c16 * 16) = st0; *(LAS u32x4*)(nb + (k0i + 64) * IDX_ROWB + c16 * 16) = st1; }
            __syncthreads();
        }
    }
}
__device__ __forceinline__ unsigned f2key(float f) { const unsigned u = __float_as_uint(f); return (u & 0x80000000u) ? ~u : (u | 0x80000000u); }
__device__ __forceinline__ void topk_phase(Frame& F) {
    const int gw = F.vcu * NWAVES + F.wave, NGW = F.G * NWAVES, lane = fresh_lane();
    const float* SC = (const float*)(F.ws + WS_SC); unsigned long long* MASK = (unsigned long long*)(F.ws + WS_MASK);
    LAS unsigned* cbuf = (LAS unsigned*)(F.lds + RING_OFF + F.wave * 8192);
    for (int row = gw; row < NX; row += NGW) {
        const int q = row & (SEQ - 1), n = NMETA + q + 1;
        const float* sr = SC + (size_t)row * TP;
        unsigned key[128]; unsigned key128;
        const int dln = 128 * lane - n;
        {
            const f32x4* lp = (const f32x4*)(sr + 128 * lane);
            const bool live = dln < 0;
#pragma unroll
            for (int j4 = 0; j4 < 32; ++j4) { f32x4 v = {0.f, 0.f, 0.f, 0.f}; if (live) v = lp[j4];
#pragma unroll
                for (int e = 0; e < 4; ++e) { const int j = 4 * j4 + e; const unsigned u = __float_as_uint(v[e]); const unsigned sgn = (unsigned)((int)u >> 31);
                    key[j] = (u ^ (sgn | 0x80000000u)) & (unsigned)((dln + j) >> 31); }
                if ((j4 & 7) == 7) __builtin_amdgcn_sched_barrier(0); }
            const unsigned u = __float_as_uint(sr[8192 + (lane & 15)]); const unsigned sgn = (unsigned)((int)u >> 31);
            key128 = (lane < 16 && 8192 + lane < n) ? (u ^ (sgn | 0x80000000u)) : 0u;
        }
        unsigned thr = 1u; bool exact = true;
        if (n > 256) {
            exact = false; bool done = false; unsigned prefix = 0u;
            unsigned ts = 1u;
            if (n > 1536) {
                ts = 0u;
                for (int bit = 31; bit >= 14; --bit) {
                    const unsigned cand = ts | (1u << bit); int cl = 0;
#pragma unroll
                    for (int i = 0; i < 8; ++i) cl += __popcll(__ballot(key[16 * i] >= cand));
                    if (cl >= 34) ts = cand;
                }
            }
            LAS unsigned* dump = cbuf + 24 * 64 + lane; int ctot = 0;
#pragma unroll
            for (int j = 0; j < 129; ++j) { const unsigned kv = j < 128 ? key[j] : key128; const bool p = kv >= ts;
                const unsigned long long m = __ballot(p);
                const int pos = ctot + (int)__builtin_amdgcn_mbcnt_hi((unsigned)(m >> 32), __builtin_amdgcn_mbcnt_lo((unsigned)m, 0u));
                LAS unsigned* a = (p && pos < 24 * 64) ? cbuf + pos : dump; *a = kv; ctot += __popcll(m);
                if ((j & 7) == 7) __builtin_amdgcn_sched_barrier(0); }
            LDS_WAIT(); asm volatile("" ::: "memory");
            if (ctot >= 256 && ctot <= 24 * 64) {
                unsigned cd[24]; const int nr = (ctot + 63) >> 6;
#pragma unroll
                for (int r = 0; r < 24; ++r) { const unsigned v = cbuf[64 * r + lane]; cd[r] = (64 * r + lane < ctot) ? v : 0u; }
                for (int bit = 31; bit >= 0; --bit) {
                    const unsigned cand = prefix | (1u << bit); int cnt = 0;
#pragma unroll
                    for (int r = 0; r < 24; ++r) if (r < nr) cnt += __popcll(__ballot(cd[r] >= cand));
                    if (cnt >= 256) { prefix = cand; if (cnt == 256) { exact = true; break; } }
                }
                done = true;
            }
            LDS_WAIT(); asm volatile("" ::: "memory");
            if (!done) {
                prefix = 0u; exact = false;
                for (int bit = 31; bit >= 0; --bit) {
                    const unsigned cand = prefix | (1u << bit); int cl = (key128 >= cand) ? 1 : 0;
#pragma unroll
                    for (int j = 0; j < 128; ++j) cl += (key[j] >= cand) ? 1 : 0;
#pragma unroll
                    for (int o = 1; o < 64; o <<= 1) cl += __shfl_xor(cl, o);
                    const int cnt = __builtin_amdgcn_readfirstlane(cl);
                    if (cnt >= 256) { prefix = cand; if (cnt == 256) { exact = true; break; } }
                }
            }
            thr = prefix;
        }
        unsigned w0 = 0u, w1 = 0u, w2 = 0u, w3 = 0u; unsigned long long wx;
        if (__builtin_expect(exact, 1)) {
#pragma unroll
            for (int j = 31; j >= 0; --j) { w0 = w0 + w0 + ((key[j] >= thr) ? 1u : 0u); w1 = w1 + w1 + ((key[32 + j] >= thr) ? 1u : 0u); w2 = w2 + w2 + ((key[64 + j] >= thr) ? 1u : 0u); w3 = w3 + w3 + ((key[96 + j] >= thr) ? 1u : 0u); }
            wx = __ballot(key128 >= thr);
        } else {
            unsigned thr2 = thr; asm volatile("" : "+v"(thr2));
            int cg = (key128 > thr2) ? 1 : 0, ce = 0;
#pragma unroll
            for (int j = 0; j < 128; ++j) { cg += (key[j] > thr2) ? 1 : 0; ce += (key[j] == thr2) ? 1 : 0; }
            int cgt = cg;
#pragma unroll
            for (int o = 1; o < 64; o <<= 1) cgt += __shfl_xor(cgt, o);
            const int need = 256 - __builtin_amdgcn_readfirstlane(cgt);
            int incl = ce;
#pragma unroll
            for (int o = 1; o < 64; o <<= 1) { const int t = __shfl_up(incl, o); if (lane >= o) incl += t; }
            const int before = incl - ce; const int etot = __shfl(incl, 63);
            int allow = need - before; allow = allow < 0 ? 0 : allow;
            int seen = 0;
#define TK_BIT(W, J) { const unsigned kv_ = key[J]; const bool eq_ = kv_ == thr; const bool tk_ = (kv_ > thr) || (eq_ && seen < allow); seen += eq_ ? 1 : 0; W |= tk_ ? (1u << ((J) & 31)) : 0u; }
#pragma unroll
            for (int j = 0; j < 32; ++j) TK_BIT(w0, j)
#pragma unroll
            for (int j = 32; j < 64; ++j) TK_BIT(w1, j)
#pragma unroll
            for (int j = 64; j < 96; ++j) TK_BIT(w2, j)
#pragma unroll
            for (int j = 96; j < 128; ++j) TK_BIT(w3, j)
#undef TK_BIT
            const bool eqx = key128 == thr; const unsigned long long mx = __ballot(eqx);
            const int rankx = etot + (int)__builtin_amdgcn_mbcnt_hi((unsigned)(mx >> 32), __builtin_amdgcn_mbcnt_lo((unsigned)mx, 0u));
            wx = __ballot((key128 > thr) || (eqx && rankx < need));
        }
        unsigned long long* mr = MASK + (size_t)row * 129;
        *(u32x4*)(mr + 2 * lane) = (u32x4){w0, w1, w2, w3};
        if (lane == 0) mr[128] = wx & 0xffffull;
    }
}

struct Args { const float* in[20]; float* out; unsigned char* ws; int ph_lo, ph_hi, li, pad; };
constexpr int NPHASE = 13;

__global__ void __launch_bounds__(NTHR, 2) mega(Args args) {
    extern __shared__ __attribute__((aligned(16))) unsigned char lds_raw[];
    Frame F;
    F.lds = (LAS unsigned char*)lds_raw;
    F.MISC = (volatile LAS unsigned*)(F.lds + MISC_OFF);
    F.wave = __builtin_amdgcn_readfirstlane(threadIdx.x >> 6);
    F.G = gridDim.x; { const int bx = blockIdx.x; F.vcu = (F.G % 8 == 0) ? (bx % 8) * (F.G / 8) + bx / 8 : bx; }
    F.ws = args.ws; F.ctl = (unsigned*)(args.ws + WS_CTL); F.out = args.out;
#pragma unroll
    for (int i = 0; i < 20; ++i) F.in[i] = args.in[i];
    for (int u = (int)threadIdx.x; u < (LDS_BYTES - LDSCTL_OFF) / 4; u += NTHR) ((LAS unsigned*)(F.lds + LDSCTL_OFF))[u] = 0u;
    __syncthreads();
    XcdBarrier bar = xcd_barrier_post(F.ctl + CW_BAR + args.li * XCD_BAR_WORDS, F.MISC + 8); bar.wave = F.wave;
    const int lo = args.ph_lo, hi = args.ph_hi;
    unsigned char* ws = F.ws;
    volatile LAS int* tb = (volatile LAS int*)(F.lds + MOE_TB_OFF); volatile LAS int* cnt = (volatile LAS int*)(F.lds + MOE_CNT_OFF);
#define IN(k) (lo <= (k) && (k) < hi)
#define SEAM(k) do { if (IN(k) && hi > (k) + 1) xcd_barrier(bar); } while (0)
    if (IN(0)) { p0_prologue(F); SEAM(0); }
    if (IN(1)) {
        {
            WindowOrder S; S.init(MROWS / 256, GATE_TILE0 + 1, 0, F.G, (int)blockIdx.x);
            struct Remap { WindowOrder w; __device__ bool next(int i, Unit& u) const { if (!w.next(i, u)) return false; if (u.pn == GATE_TILE0) u.pn = 44; return true; } __device__ __forceinline__ int rows(const Unit&) const { return 256; } } R{S};
            DenseAB P{(const char*)(ws + WS_HN), (const char*)(ws + WS_WIN), D, D};
            EpiInProj E{ws, 1.0f};
            gemm_phase(F.lds + RING_OFF, 2 * D, R, P, E, F.wave);
        }
        {
            struct GateOrder { DenseOrder d; int c, G, nb8;
                __device__ bool next(int i, Unit& u) const {
                    int L;
                    if (G != 256) { L = i * G + c; if (L >= 1024) return false; }
                    else if (i < 3) L = i * 256 + c;
                    else if (i == 3 && c >= nb8) L = 768 + (c - nb8);
                    else if (i == 4 && c >= nb8 && c < 2 * nb8) L = 768 + (256 - nb8) + (c - nb8);
                    else return false;
                    DenseOrder t = d; t.c = L % G; if (!t.next(L / G, u)) return false; u.pn += GATE_TILE0; return true; }
                __device__ __forceinline__ int rows(const Unit&) const { return 256; } };
            GateOrder S; S.d.init(NX / 256, 16, F.G, 0); S.c = (int)blockIdx.x; S.G = F.G; S.nb8 = ((MROWS / 256) * (GATE_TILE0 + 1)) % 256;
            DenseAB8 P{(const char*)(ws + WS_HN8), (const char*)(ws + WS_WIN8), D, D, GATE_TILE0};
            EpiInProj E{ws, F8_WINV};
            gemm_phase<true>(F.lds + RING_OFF, D, S, P, E, F.wave);
        }
        SEAM(1);
    }
    if (IN(2)) { idx_phase(F); SEAM(2); }
    if (IN(3)) { topk_phase(F); SEAM(3); }
    if (IN(4)) { attn_phase(F); SEAM(4); }
    if (IN(5)) { diff_phase(F); SEAM(5); }
    if (IN(6)) {
        DenseOrder S; S.init(NX / 256, D / 256, F.G, (int)blockIdx.x);
        DenseAB8 P{(const char*)(ws + WS_OA8), (const char*)(ws + WS_WUPA), D, D, 0};
        EpiUp E{(const bf16_t*)(ws + WS_GA), (const bf16_t*)(ws + WS_GB), ws + WS_MG, 1.0f / OA8_SCALE, F8_WINV};
        gemm_phase<true>(F.lds + RING_OFF, D, S, P, E, F.wave);
        SEAM(6);
    }
    if (IN(8)) {
        DenseOrder S; S.init(NX / 256, D / 256, F.G, (int)blockIdx.x);
        DenseAB8 P{(const char*)(ws + WS_MG), (const char*)(ws + WS_WOUT), D, D, 0};
        EpiOut E{F.in[0], (bf16_t*)(ws + WS_H1), F8_WINV};
        gemm_phase<true>(F.lds + RING_OFF, D, S, P, E, F.wave);
        SEAM(8);
    }
    if (IN(9)) { router_phase(F); SEAM(9); }
    if (IN(10)) {
        moe_tables(F);
        MoeOrder S{F.G, (int)blockIdx.x, 4096 / 256, tb};
        MoeAB1 P{(const char*)(ws + WS_HB), (const char*)(ws + WS_W1), (const int*)(ws + WS_LIST), tb, cnt};
        EpiMoe1 E{F.in[16], ws + WS_G};
        gemm_phase<true>(F.lds + RING_OFF, D, S, P, E, F.wave);
        SEAM(10);
    }
    if (IN(11)) {
        moe_tables(F);
        MoeOrder S{F.G, (int)blockIdx.x, D / 256, tb};
        MoeAB2 P{(const char*)(ws + WS_G), (const char*)(ws + WS_W2)};
        EpiMoe2 E{F.in[18], (bf16_t*)(ws + WS_Y)};
        gemm_phase<true>(F.lds + RING_OFF, DFF, S, P, E, F.wave);
        SEAM(11);
    }
    if (IN(12)) { moe_tables(F); final_phase(F); }
#undef IN
#undef SEAM
}

}
#ifndef MK_PER_PHASE
#define MK_PER_PHASE 0
#endif
extern "C" void kernel_launch(void* const* d_in, const int* in_sizes, int n_in, void* d_out, int out_size, void* d_ws, size_t ws_size, hipStream_t stream) {
    static int grid = 0;
    if (grid == 0) {
        if (n_in != 20 || out_size != mk::NX * mk::D || ws_size < mk::WS_END2) { fprintf(stderr, "kernel_launch: unexpected problem shape or workspace (n_in %d, out %d, ws %zu < %zu)\n", n_in, out_size, ws_size, (size_t)mk::WS_END2); grid = -1; return; }
        int dev = 0, cus = 0;
        if (hipGetDevice(&dev) != hipSuccess || hipDeviceGetAttribute(&cus, hipDeviceAttributeMultiprocessorCount, dev) != hipSuccess) { grid = -1; return; }
        if (hipFuncSetAttribute((const void*)mk::mega, hipFuncAttributeMaxDynamicSharedMemorySize, mk::LDS_BYTES) != hipSuccess) { fprintf(stderr, "hipFuncSetAttribute failed\n"); grid = -1; return; }
        int per_cu = 0; (void)hipOccupancyMaxActiveBlocksPerMultiprocessor(&per_cu, (const void*)mk::mega, mk::NTHR, mk::LDS_BYTES); (void)hipGetLastError();
        grid = cus;
    }
    if (grid < 0) return;
    (void)hipMemsetAsync((char*)d_ws + mk::WS_CTL, 0, mk::CTL_BYTES, stream);
    mk::Args a{};
    for (int i = 0; i < 20; ++i) a.in[i] = (const float*)d_in[i];
    a.out = (float*)d_out; a.ws = (unsigned char*)d_ws;
#if MK_PER_PHASE
    for (int ph = 0; ph < mk::NPHASE; ++ph) { a.ph_lo = ph; a.ph_hi = ph + 1; a.li = ph; hipLaunchKernelGGL(mk::mega, dim3(grid), dim3(mk::NTHR), mk::LDS_BYTES, stream, a); }
#else
    a.ph_lo = 0; a.ph_hi = mk::NPHASE; a.li = 0;
    hipLaunchKernelGGL(mk::mega, dim3(grid), dim3(mk::NTHR), mk::LDS_BYTES, stream, a);
#endif
}
```

```cpp
#include <hip/hip_runtime.h>
#include <cstdio>
#include <cstdint>
#include <cmath>

namespace mk {
#define LAS __attribute__((address_space(3)))
#define GAS __attribute__((address_space(1)))
typedef unsigned short bf16_t;
typedef short bf16x8 __attribute__((ext_vector_type(8)));
typedef float f32x4 __attribute__((ext_vector_type(4)));
typedef float f32x2 __attribute__((ext_vector_type(2)));
typedef unsigned u32x4 __attribute__((ext_vector_type(4)));
typedef unsigned u32x2 __attribute__((ext_vector_type(2)));

constexpr int NWAVES = 8, NTHR = 512;
constexpr int D = 2048, SEQ = 8192, NX = 16384, NMETA = 16, T = 8208, TP = 8256;
constexpr int MROWS = 16640;
constexpr int NIN = 11520;
constexpr int DIN = 11344;
constexpr int NE = 32, DFF = 2048;
constexpr float EPS = 1e-5f;
constexpr size_t al256(size_t x) { return (x + 255) & ~(size_t)255; }
constexpr size_t WS_CTL = 0, CTL_BYTES = 1u << 20;
constexpr size_t WS_ROPE = WS_CTL + CTL_BYTES;
constexpr size_t WS_ROPEI = WS_ROPE + al256((size_t)T * 64 * 8);
constexpr size_t WS_WIN = WS_ROPEI + al256((size_t)T * 32 * 8);
constexpr size_t WS_WUPA = WS_WIN + (size_t)NIN * D * 2;
constexpr size_t WS_WUPB = WS_WUPA + (size_t)D * 1024 * 2;
constexpr size_t WS_WOUT = WS_WUPB + (size_t)D * 1024 * 2;
constexpr size_t WS_W1 = WS_WOUT + (size_t)D * D * 2;
constexpr size_t WS_W2 = WS_W1 + (size_t)NE * 4096 * D * 2;
constexpr size_t WS_WR = WS_W2 + (size_t)NE * D * DFF * 2;
constexpr size_t WS_HN = WS_WR + (size_t)2 * NE * D * 2;
constexpr size_t WS_QA = WS_HN + (size_t)MROWS * D * 2;
constexpr size_t WS_KA = WS_QA + (size_t)NX * 1024 * 2;
constexpr size_t WS_VA = WS_KA + (size_t)2 * TP * 1024 * 2;
constexpr size_t WS_QI = WS_VA + (size_t)2 * TP * 1024 * 2;
constexpr size_t WS_KI = WS_QI + (size_t)NX * 1024 * 2;
constexpr size_t WS_WI = WS_KI + (size_t)2 * TP * 64 * 2;
constexpr size_t WS_QB = WS_WI + (size_t)NX * 16 * 4;
constexpr size_t WS_KB = WS_QB + (size_t)NX * 1024 * 2;
constexpr size_t WS_VB = WS_KB + (size_t)2 * TP * 1024 * 2;
constexpr size_t WS_GA = WS_VB + (size_t)2 * TP * 1024 * 2;
constexpr size_t WS_GB = WS_GA + (size_t)NX * D * 2;
constexpr size_t WS_END1 = WS_GB + (size_t)NX * D * 2;
constexpr int GATE_TILE0 = 28, GATE_COL0 = 7248;
constexpr int MAXL = 16384;
constexpr int MAXT = 288;
constexpr size_t WS_OA = WS_END1;
constexpr size_t WS_OB = WS_OA + (size_t)NX * 1024 * 2;
constexpr size_t WS_MGF = WS_OB + (size_t)NX * 1024 * 2;
constexpr size_t WS_MG = WS_MGF + (size_t)NX * D * 4;
constexpr size_t WS_H1 = WS_MG + (size_t)NX * D * 2;
constexpr size_t WS_HB = WS_H1 + (size_t)NX * D * 4;
constexpr size_t WS_GATE = WS_HB + (size_t)NX * D * 2;
constexpr size_t WS_SEI = WS_GATE + (size_t)NX * 4 * 4;
constexpr size_t WS_LIST = WS_SEI + (size_t)NX * 4 * 4;
constexpr size_t WS_G = WS_LIST + (size_t)NE * MAXL * 4;
constexpr size_t WS_Y = WS_G + (size_t)MAXT * 256 * DFF * 2;
constexpr size_t WS_MASK = WS_Y + (size_t)MAXT * 256 * D * 2;
constexpr size_t WS_OALL = WS_MASK + al256((size_t)NX * 129 * 8);
constexpr size_t WS_SC = WS_OALL + (size_t)NX * 3072 * 2;
constexpr size_t WS_END2 = WS_SC + (size_t)NX * TP * 4;

constexpr size_t WS_WIN8 = WS_OA, WS_HN8 = WS_MGF;
constexpr size_t WS_OA8 = WS_SC;
constexpr float OA8_SCALE = 16.0f;
constexpr int CW_BAR = 4096;
constexpr int CW_CNT = 65536;

constexpr int RING_OFF = 0, RING_BYTES = 131072;
constexpr int LDSCTL_OFF = RING_BYTES, MISC_OFF = LDSCTL_OFF + 320;
constexpr int MOE_TB_OFF = LDSCTL_OFF + 1024, MOE_CNT_OFF = LDSCTL_OFF + 1280;
constexpr int LDS_BYTES = 163840;

typedef __bf16 bf16x2_t __attribute__((ext_vector_type(2)));
__device__ __forceinline__ unsigned cvt_pk_bf16(float lo, float hi) { f32x2 v = {lo, hi}; bf16x2_t b = __builtin_convertvector(v, bf16x2_t); return __builtin_bit_cast(unsigned, b); }
typedef int i32x4 __attribute__((ext_vector_type(4)));
typedef int i32x8 __attribute__((ext_vector_type(8)));
constexpr float F8_WSCALE = 64.0f, F8_WINV = 1.0f / 64.0f;
__device__ __forceinline__ unsigned cvt4_fp8(float a, float b, float c, float d) { int w = 0; w = __builtin_amdgcn_cvt_pk_fp8_f32(a, b, w, false); w = __builtin_amdgcn_cvt_pk_fp8_f32(c, d, w, true); return (unsigned)w; }
__device__ __forceinline__ float bf2f(bf16_t b) { return __uint_as_float(((unsigned)b) << 16); }
__device__ __forceinline__ unsigned f2bf(float f) { unsigned u = __float_as_uint(f); return (u + 0x7fffu + ((u >> 16) & 1u)) >> 16; }
__device__ __forceinline__ int fresh_lane() { int l = (int)__builtin_amdgcn_mbcnt_hi(~0u, __builtin_amdgcn_mbcnt_lo(~0u, 0u)); asm volatile("" : "+v"(l)); return l; }
#define LDS_WAIT() asm volatile("s_waitcnt lgkmcnt(0)" ::: "memory")
#define VM_WAIT() asm volatile("s_waitcnt vmcnt(0)" ::: "memory")

#define XB_TMO      128
#define XB_XCNT(j)  (256  + 64 * (j))
#define XB_XSUB(j)  (1280 + 64 * (j))
#define XB_XGEN(j)  (2304 + 64 * (j))
#define XB_TOP      3328
#define XB_TOPGEN   3392
#define XCD_BAR_WORDS 3456
#define XB_SPIN_CAP (1u << 18)
__device__ __forceinline__ unsigned xb_ld(unsigned* p)              { return __hip_atomic_load(p, __ATOMIC_RELAXED, __HIP_MEMORY_SCOPE_AGENT); }
__device__ __forceinline__ unsigned xb_add(unsigned* p, unsigned v) { return __hip_atomic_fetch_add(p, v, __ATOMIC_RELAXED, __HIP_MEMORY_SCOPE_AGENT); }
__device__ __forceinline__ unsigned xb_xcc_id() { return (unsigned)__builtin_amdgcn_s_getreg((3 << 11) | 20) & 0xFu; }
#define XB_SPIN(cond, bar) do { unsigned _sp = 0; while (cond) { __builtin_amdgcn_s_sleep(1); \
    if ((++_sp & 255u) == 0u) { if (xb_ld(&(bar)[XB_TMO])) break; if (_sp > XB_SPIN_CAP) { atomicAdd(&(bar)[XB_TMO], 1u); break; } } } } while (0)
struct XcdBarrier { unsigned* bar; unsigned x; volatile LAS unsigned* st; int wave; };
__device__ __forceinline__ XcdBarrier xcd_barrier_post(unsigned* bar, volatile LAS unsigned* st) {
    XcdBarrier b; b.bar = bar; b.x = xb_xcc_id(); b.st = st;
    if (__builtin_amdgcn_readfirstlane(threadIdx.x >> 6) == 0 && fresh_lane() == 0) (void)xb_add(&bar[XB_XCNT(b.x)], 1u);
    return b;
}
__device__ __forceinline__ void xcd_barrier_complete(unsigned* bar, unsigned x, unsigned& nloc, unsigned& nx) {
    const unsigned G = gridDim.x * gridDim.y * gridDim.z;
    unsigned sum, cnt, mine, sp = 0u;
    for (;;) {
        sum = 0u; cnt = 0u; mine = 0u;
#pragma unroll
        for (unsigned j = 0; j < 16; ++j) { const unsigned c = xb_ld(&bar[XB_XCNT(j)]); sum += c; cnt += (c > 0u) ? 1u : 0u; mine = (j == x) ? c : mine; }
        if (sum == G) break;
        __builtin_amdgcn_s_sleep(1);
        if ((++sp & 255u) == 0u) { if (xb_ld(&bar[XB_TMO])) break; if (sp > XB_SPIN_CAP) { atomicAdd(&bar[XB_TMO], 1u); break; } }
    }
    nloc = mine > 0u ? mine : 1u; nx = cnt > 0u ? cnt : 1u;
}
__device__ __forceinline__ void xcd_barrier(const XcdBarrier& b) {
    asm volatile("s_waitcnt vmcnt(0)" ::: "memory");
    __syncthreads();
    if (b.wave == 0 && fresh_lane() == 0) {
        unsigned* bar = b.bar;
        __builtin_amdgcn_s_waitcnt(0);
        unsigned nloc = b.st[0], nx = b.st[1];
        if (nloc == 0u) { xcd_barrier_complete(bar, b.x, nloc, nx); b.st[0] = nloc; b.st[1] = nx; }
        const unsigned old = xb_add(&bar[XB_XSUB(b.x)], 1u);
        const unsigned gen = old / nloc;
        if (old + 1u == (gen + 1u) * nloc) {
            __builtin_amdgcn_fence(__ATOMIC_RELEASE, "agent");
            asm volatile("s_waitcnt vmcnt(0)" ::: "memory");
            const unsigned og = xb_add(&bar[XB_TOP], 1u);
            const unsigned tg = og / nx;
            if (og + 1u == (tg + 1u) * nx) xb_add(&bar[XB_TOPGEN], 1u);
            else XB_SPIN(xb_ld(&bar[XB_TOPGEN]) == tg, bar);
            __builtin_amdgcn_fence(__ATOMIC_ACQUIRE, "agent");
            xb_add(&bar[XB_XGEN(b.x)], 1u);
            asm volatile("s_waitcnt vmcnt(0)" ::: "memory");
        } else {
            XB_SPIN(xb_ld(&bar[XB_XGEN(b.x)]) == gen, bar);
            __builtin_amdgcn_fence(__ATOMIC_ACQUIRE, "agent");
            asm volatile("s_waitcnt vmcnt(0)" ::: "memory");
        }
    }
    __syncthreads();
}

constexpr int BM = 256, BK = 64, HALF = 128, HTB = HALF * BK * 2, STAGE_BYTES = 8 * HTB, NXCD = 8, WGM = 8;
__host__ __device__ __forceinline__ int lds_byte(int r, int c) { const int st = (r >> 4) * 2 + (c >> 5), rr = r & 15, cc = c & 31, ob = rr * 64 + cc * 2; return st * 1024 + (ob ^ (((ob >> 9) & 1) << 5)); }
__host__ __device__ __forceinline__ void stage_rc(int b, int& R, int& C) { const int st = b / 1024, sb = b % 1024, swz = sb ^ (((sb >> 9) & 1) << 5); R = (st >> 1) * 16 + swz / 64; C = (st & 1) * 32 + (swz % 64) / 2; }
__host__ __device__ __forceinline__ int perm32(int rho) { const int n = rho >> 4, i = rho & 15; return 8 * (i >> 2) + 4 * n + (i & 3); }
struct Unit { int pm, pn, ex; };
struct DenseOrder {
    int nM, nN, nwg, G, c;
    __device__ void init(int nM_, int nN_, int G_, int c_) { nM = nM_; nN = nN_; nwg = nM * nN; G = G_; c = c_; }
    __device__ bool next(int i, Unit& u) const {
        const long L = (long)i * G + c; if (L >= nwg) return false;
        int wgid = (int)L; { const int q = nwg / NXCD, r = nwg % NXCD, xcd = wgid % NXCD, off = wgid / NXCD; wgid = (xcd < r ? xcd * (q + 1) : r * (q + 1) + (xcd - r) * q) + off; }
        const int nig = WGM * nN, gid = wgid / nig, fm = gid * WGM, gsz = (nM - fm) < WGM ? (nM - fm) : WGM;
        u.pm = fm + ((wgid % nig) % gsz); u.pn = (wgid % nig) / gsz; u.ex = 0; return true;
    }
};
struct DenseAB {
    const char* Ab; const char* Bb; int K; int lda;
    __device__ __forceinline__ const char* a_base(const Unit& u) const { return Ab + (size_t)u.pm * 256 * lda * 2; }
    __device__ __forceinline__ const char* b_base(const Unit& u) const { return Bb + (size_t)u.pn * 256 * K * 2; }
    __device__ __forceinline__ void a_voff(const Unit&, const int (&R)[2], const int (&C)[2], unsigned (&v)[4]) const {
#pragma unroll
        for (int i = 0; i < 2; ++i) { v[i] = (unsigned)(R[i] * lda + C[i]) * 2u; v[2 + i] = (unsigned)((R[i] + HALF) * lda + C[i]) * 2u; } }
};

struct DenseAB8 {
    const char* Ab; const char* Bb; int KB; int ldaB; int pn0;
    __device__ __forceinline__ const char* a_base(const Unit& u) const { return Ab + (size_t)u.pm * 256 * ldaB; }
    __device__ __forceinline__ const char* b_base(const Unit& u) const { return Bb + (size_t)(u.pn - pn0) * 256 * KB; }
    __device__ __forceinline__ void a_voff(const Unit&, const int (&R)[2], const int (&C)[2], unsigned (&v)[4]) const {
#pragma unroll
        for (int i = 0; i < 2; ++i) { v[i] = (unsigned)(R[i] * ldaB + 2 * C[i]); v[2 + i] = (unsigned)((R[i] + HALF) * ldaB + 2 * C[i]); } }
};
struct WindowOrder { DenseOrder d; int pn0;
    __device__ void init(int nM, int nN, int pn0_, int G, int c) { d.init(nM, nN, G, c); pn0 = pn0_; }
    __device__ bool next(int i, Unit& u) const { if (!d.next(i, u)) return false; u.pn += pn0; return true; } };
template <class E_> struct has_mid { template <class T> static constexpr bool test(decltype(T::HAS_MID)*) { return T::HAS_MID; } template <class T> static constexpr bool test(...) { return false; } static constexpr bool value = test<E_>(nullptr); };
template <bool F8 = false, class Epi, class Sched, class AB>
__device__ __forceinline__ void gemm_phase(LAS unsigned char* lds, int KB, const Sched& S, const AB& P, const Epi& E, int wave_) {
    const int wid = wave_, lane = fresh_lane(), tid = wid * 64 + lane, wr = wid >> 2, wc = wid & 3, fr = lane & 15, fq = lane >> 4;
    const int nt = KB / (BK * 2);
    int Rr[2], Cc[2]; unsigned voffB[2];
#pragma unroll
    for (int i = 0; i < 2; ++i) { stage_rc(tid * 16 + i * 8192, Rr[i], Cc[i]); const int Rb = (Rr[i] & ~31) + perm32(Rr[i] & 31); voffB[i] = (unsigned)(Rb * KB + 2 * Cc[i]); }
    const size_t kstep = (size_t)(BK * 2);
    const size_t hstep = (size_t)HALF * KB;
    const unsigned ldsw = (unsigned)wid * 1024u;
    const int aoff = lds_byte(wr * 64 + fr, fq * 8), boff = lds_byte(wc * 32 + fr, fq * 8);
#define PG8_SA(b, h) (((b) * 2 + (h)) * HTB)
#define PG8_SB(b, h) ((4 + (b) * 2 + (h)) * HTB)
#define PG8_STAGE2(bufoff, gbase, v0, v1) do { \
        __builtin_amdgcn_global_load_lds((const unsigned*)((const char*)(gbase) + (v0)), (LAS unsigned*)(lds + (bufoff) + ldsw), 16, 0, 0); \
        __builtin_amdgcn_global_load_lds((const unsigned*)((const char*)(gbase) + (v1)), (LAS unsigned*)(lds + (bufoff) + ldsw + 8192), 16, 0, 0); } while (0)
#define PG8_STAGEB(bufoff, gbase) PG8_STAGE2(bufoff, gbase, voffB[0], voffB[1])
#define PG8_LDA(dst, b, h) do { _Pragma("unroll") for (int m = 0; m < 4; ++m) _Pragma("unroll") for (int k = 0; k < 2; ++k) dst[m][k] = *(const LAS bf16x8*)(lds + PG8_SA(b, h) + aoff + m * 2048 + k * 1024); } while (0)
#define PG8_LDB(dst, b, h) do { _Pragma("unroll") for (int n = 0; n < 2; ++n) _Pragma("unroll") for (int k = 0; k < 2; ++k) dst[n][k] = *(const LAS bf16x8*)(lds + PG8_SB(b, h) + boff + n * 2048 + k * 1024); } while (0)
#define PG8_CAT(x0, x1) __builtin_shufflevector(__builtin_bit_cast(i32x4, x0), __builtin_bit_cast(i32x4, x1), 0, 1, 2, 3, 4, 5, 6, 7)
#define PG8_MMA(ai, bj, At, Bt) do { __builtin_amdgcn_s_setprio(1); _Pragma("unroll") for (int m = 0; m < 4; ++m) _Pragma("unroll") for (int n = 0; n < 2; ++n) { \
        if constexpr (F8) { const i32x8 a8_ = PG8_CAT(Bt[n][0], Bt[n][1]), b8_ = PG8_CAT(At[m][0], At[m][1]);   \
            asm volatile("v_mfma_f32_16x16x128_f8f6f4 %0, %1, %2, %0" : "+v"(acc[ai][bj][m][n]) : "v"(a8_), "v"(b8_)); }     \
        else { _Pragma("unroll") for (int k = 0; k < 2; ++k) acc[ai][bj][m][n] = __builtin_amdgcn_mfma_f32_16x16x32_bf16(Bt[n][k], At[m][k], acc[ai][bj][m][n], 0, 0, 0); } } \
        __builtin_amdgcn_s_setprio(0); } while (0)
#define PG8_WAIT_V(n) asm volatile("s_waitcnt vmcnt(" #n ")" ::: "memory")
#define PG8_WAIT_L(n) asm volatile("s_waitcnt lgkmcnt(" #n ")" ::: "memory")
#define PG8_BAR __builtin_amdgcn_s_barrier()
#define PG8_SCHED __builtin_amdgcn_sched_barrier(0)
    Unit cur, nxt; int ui = 0;
    if (!S.next(0, cur)) return;
    f32x4 acc[2][2][4][2];
#pragma unroll
    for (int a = 0; a < 2; ++a)
#pragma unroll
        for (int b = 0; b < 2; ++b)
#pragma unroll
            for (int m = 0; m < 4; ++m)
#pragma unroll
                for (int n = 0; n < 2; ++n) acc[a][b][m][n] = (f32x4){0.f, 0.f, 0.f, 0.f};
    bf16x8 At[4][2], B0[2][2], B1[2][2];
    const int f8scale = 0x7f7f7f7f;
    const char* cA = P.a_base(cur); const char* cB = P.b_base(cur);
    unsigned cvo[4], nvo[4];
    P.a_voff(cur, Rr, Cc, cvo);
    PG8_STAGEB(PG8_SB(0, 0), cB); PG8_STAGEB(PG8_SB(0, 1), cB + hstep); PG8_STAGE2(PG8_SA(0, 0), cA, cvo[0], cvo[1]); PG8_STAGE2(PG8_SA(0, 1), cA, cvo[2], cvo[3]);
    if (wr == 1) PG8_BAR;
    PG8_WAIT_V(2); PG8_BAR;
    PG8_STAGEB(PG8_SB(1, 0), cB + kstep); PG8_STAGE2(PG8_SA(1, 0), cA + kstep, cvo[0], cvo[1]); PG8_STAGEB(PG8_SB(1, 1), cB + hstep + kstep);
    PG8_WAIT_V(6); PG8_BAR;
    for (;;) {
        const bool has_next = S.next(ui + 1, nxt);
        const char* nA = cA; const char* nB = cB;
#pragma unroll
        for (int i = 0; i < 4; ++i) nvo[i] = cvo[i];
        if (has_next) { nA = P.a_base(nxt); nB = P.b_base(nxt); P.a_voff(nxt, Rr, Cc, nvo); }
        for (int t = 0; t < nt; t += 2) {
            if constexpr (has_mid<Epi>::value) { if (t == nt / 2) { Epi& Em = const_cast<Epi&>(E); Em.mid(acc, cur, wr, wc, fr, fq); } }
            const bool last = (t == nt - 2);
            const char* a1 = cA + (size_t)(t + 1) * kstep;
            const char* a2 = last ? nA : cA + (size_t)(t + 2) * kstep; const char* b2 = last ? nB : cB + (size_t)(t + 2) * kstep;
            const char* a3 = a2 + kstep; const char* b3 = b2 + kstep;
            const unsigned x0 = last ? nvo[0] : cvo[0], x1 = last ? nvo[1] : cvo[1], x2 = last ? nvo[2] : cvo[2], x3 = last ? nvo[3] : cvo[3];
            PG8_LDB(B0, 0, 0); PG8_LDB(B1, 0, 1); PG8_SCHED; PG8_LDA(At, 0, 0); PG8_STAGE2(PG8_SA(1, 1), a1, cvo[2], cvo[3]);
            PG8_WAIT_V(8); PG8_WAIT_L(0); PG8_BAR; PG8_MMA(0, 0, At, B0); PG8_MMA(0, 1, At, B1); PG8_BAR; PG8_SCHED;
            PG8_LDA(At, 0, 1); PG8_STAGEB(PG8_SB(0, 0), b2); PG8_STAGEB(PG8_SB(0, 1), b2 + hstep); PG8_STAGE2(PG8_SA(0, 0), a2, x0, x1);
            PG8_WAIT_V(8); PG8_WAIT_L(0); PG8_BAR; PG8_MMA(1, 0, At, B0); PG8_MMA(1, 1, At, B1); PG8_BAR; PG8_SCHED;
            PG8_LDB(B0, 1, 0); PG8_LDB(B1, 1, 1); PG8_SCHED; PG8_LDA(At, 1, 0); PG8_STAGE2(PG8_SA(0, 1), a2, x2, x3);
            PG8_WAIT_V(8); PG8_WAIT_L(0); PG8_BAR; PG8_MMA(0, 0, At, B0); PG8_MMA(0, 1, At, B1); PG8_BAR; PG8_SCHED;
            PG8_LDA(At, 1, 1); PG8_STAGEB(PG8_SB(1, 0), b3); PG8_STAGEB(PG8_SB(1, 1), b3 + hstep); PG8_STAGE2(PG8_SA(1, 0), a3, x0, x1);
            PG8_WAIT_V(8); PG8_WAIT_L(0); PG8_BAR; PG8_MMA(1, 0, At, B0); PG8_MMA(1, 1, At, B1); PG8_BAR; PG8_SCHED;
        }
        if (wr == 0) PG8_BAR;
        E(acc, cur, wr, wc, fr, fq);
        if (!has_next) break;
#pragma unroll
        for (int a = 0; a < 2; ++a)
#pragma unroll
            for (int b = 0; b < 2; ++b)
#pragma unroll
                for (int m = 0; m < 4; ++m)
#pragma unroll
                    for (int n = 0; n < 2; ++n) acc[a][b][m][n] = (f32x4){0.f, 0.f, 0.f, 0.f};
        cur = nxt; cA = nA; cB = nB; ++ui;
#pragma unroll
        for (int i = 0; i < 4; ++i) cvo[i] = nvo[i];
        if (wr == 1) PG8_BAR;
    }
    PG8_WAIT_V(0);
    PG8_BAR;
#undef PG8_SA
#undef PG8_SB
#undef PG8_STAGE2
#undef PG8_STAGEB
#undef PG8_LDA
#undef PG8_LDB
#undef PG8_MMA
#undef PG8_CAT
#undef PG8_WAIT_V
#undef PG8_WAIT_L
#undef PG8_BAR
#undef PG8_SCHED
}

struct Frame {
    LAS unsigned char* lds; volatile LAS unsigned* MISC; unsigned* ctl;
    int wave, vcu, G;
    const float* in[20]; float* out; unsigned char* ws;
};
__device__ __forceinline__ float wave_sum(float v) {
#pragma unroll
    for (int o = 1; o < 64; o <<= 1) v += __shfl_xor(v, o);
    return v;
}

__host__ __device__ __forceinline__ int perm128(int c) { return ((c >> 6) & 1) * 128 + (c >> 7) * 64 + (c & 63); }
__host__ __device__ __forceinline__ int perm64(int c) { return ((c >> 5) & 1) * 128 + (c >> 6) * 32 + (c & 31); }
__host__ __device__ __forceinline__ int win_dest(int n) {
    if (n < 1024) return 0 * 256 + (n >> 8) * 256 + perm128(n & 255);
    if (n < 2048) { n -= 1024; return 4 * 256 + (n >> 8) * 256 + perm128(n & 255); }
    if (n < 3072) { n -= 2048; return 8 * 256 + n; }
    if (n < 4096) { n -= 3072; return 12 * 256 + (n >> 8) * 256 + perm64(n & 255); }
    if (n < 4160) { n -= 4096; return 44 * 256 + (n >> 5) * 128 + (n & 31); }
    if (n < 4176) { n -= 4160; return 44 * 256 + 64 + n; }
    if (n < 5200) { n -= 4176; return 16 * 256 + (n >> 8) * 256 + perm128(n & 255); }
    if (n < 6224) { n -= 5200; return 20 * 256 + (n >> 8) * 256 + perm128(n & 255); }
    if (n < 7248) { n -= 6224; return 24 * 256 + n; }
    if (n < 9296) { n -= 7248; return 28 * 256 + n; }
    n -= 9296; return 36 * 256 + n;
}

template <class DestFn>
__device__ __forceinline__ void p0_transpose_item(const float* W, int K, int N, bf16_t* WT, LAS float* scr, int item, int lane, DestFn dest, int pitch = 0) {
    if (pitch == 0) pitch = K;
    const int nblk = (N + 31) / 32, kb = item / nblk, nb = item % nblk, k0 = 64 * kb, n0 = 32 * nb;
    { const int lr = lane >> 3, lc = 4 * (lane & 7); const bool nok = (n0 + lc) < N;
      const float* wp = W + (size_t)(k0 + lr) * N + n0 + lc; f32x4 t[8];
#pragma unroll
      for (int i = 0; i < 8; ++i) t[i] = nok ? *(const f32x4*)(wp + (size_t)(8 * i) * N) : (f32x4){0.f, 0.f, 0.f, 0.f};
#pragma unroll
      for (int i = 0; i < 8; ++i) { LAS float* sp = scr + (8 * i + lr) * 33 + lc; sp[0] = t[i][0]; sp[1] = t[i][1]; sp[2] = t[i][2]; sp[3] = t[i][3]; } }
    LDS_WAIT(); asm volatile("" ::: "memory");
    const int c = lane & 7;
#pragma unroll
    for (int j = 0; j < 4; ++j) { const int n = (lane >> 3) + 8 * j; const LAS float* s = scr + (8 * c) * 33 + n;
        u32x4 o; o.x = cvt_pk_bf16(s[0 * 33], s[1 * 33]); o.y = cvt_pk_bf16(s[2 * 33], s[3 * 33]); o.z = cvt_pk_bf16(s[4 * 33], s[5 * 33]); o.w = cvt_pk_bf16(s[6 * 33], s[7 * 33]);
        if (n0 + n < N) *(GAS u32x4*)(WT + (size_t)dest(n0 + n) * pitch + k0 + 8 * c) = o; }
    LDS_WAIT(); asm volatile("" ::: "memory");
}
struct DestId { __device__ __forceinline__ int operator()(int n) const { return n; } };
struct DestWin { __device__ __forceinline__ int operator()(int n) const { return win_dest(n); } };
struct DestWin8 { __device__ __forceinline__ int operator()(int n) const { return n >= GATE_COL0 ? win_dest(n) - GATE_TILE0 * 256 : -1; } };
template <class DestFn>
__device__ __forceinline__ void p0_transpose_item_f8(const float* W, int K, int N, unsigned char* WT, LAS float* scr, int item, int lane, DestFn dest, int pitch = 0) {
    if (pitch == 0) pitch = K;
    const int nblk = (N + 31) / 32, kb = item / nblk, nb = item % nblk, k0 = 64 * kb, n0 = 32 * nb;
    { const int lr = lane >> 3, lc = 4 * (lane & 7); const bool nok = (n0 + lc) < N;
      const float* wp = W + (size_t)(k0 + lr) * N + n0 + lc; f32x4 t[8];
#pragma unroll
      for (int i = 0; i < 8; ++i) t[i] = nok ? *(const f32x4*)(wp + (size_t)(8 * i) * N) : (f32x4){0.f, 0.f, 0.f, 0.f};
#pragma unroll
      for (int i = 0; i < 8; ++i) { LAS float* sp = scr + (8 * i + lr) * 33 + lc; sp[0] = t[i][0]; sp[1] = t[i][1]; sp[2] = t[i][2]; sp[3] = t[i][3]; } }
    LDS_WAIT(); asm volatile("" ::: "memory");
    const int c = lane & 7;
#pragma unroll
    for (int j = 0; j < 4; ++j) { const int n = (lane >> 3) + 8 * j; const LAS float* s = scr + (8 * c) * 33 + n;
        u32x2 o; o.x = cvt4_fp8(s[0 * 33] * F8_WSCALE, s[1 * 33] * F8_WSCALE, s[2 * 33] * F8_WSCALE, s[3 * 33] * F8_WSCALE); o.y = cvt4_fp8(s[4 * 33] * F8_WSCALE, s[5 * 33] * F8_WSCALE, s[6 * 33] * F8_WSCALE, s[7 * 33] * F8_WSCALE);
        const int dr = (n0 + n < N) ? dest(n0 + n) : -1;
        if (dr >= 0) *(GAS u32x2*)(WT + (size_t)dr * pitch + k0 + 8 * c) = o; }
    LDS_WAIT(); asm volatile("" ::: "memory");
}

__device__ __forceinline__ void zero_row_bf16(bf16_t* p, int nelem, int lane) {
    for (int i = lane * 8; i < nelem; i += 512) *(GAS u32x4*)(p + i) = (u32x4){0u, 0u, 0u, 0u};
}

__device__ __forceinline__ void p0_prologue(Frame& F) {
    const int lane_ = fresh_lane();
    LAS float* scr = (LAS float*)(F.lds + RING_OFF + F.wave * 16384);
    const int gw = F.vcu * NWAVES + F.wave, NGW = F.G * NWAVES;
    const float* x = F.in[0]; const float* meta = F.in[1]; const float* g_mix = F.in[2]; const float* w_in = F.in[3];
    const float* w_up_a = F.in[9]; const float* w_up_b = F.in[10]; const float* w_out = F.in[11]; const float* g_ffn = F.in[12]; const float* w_router = F.in[13];
    unsigned char* ws = F.ws;
    const float* w1 = F.in[15]; const float* w2 = F.in[17];
    constexpr int I_IN = (D / 64) * ((DIN + 31) / 32), I_UP = (1024 / 64) * (D / 32), I_OUT = (D / 64) * (D / 32), I_W1 = (D / 64) * (4096 / 32), I_W2 = (DFF / 64) * (D / 32);
    constexpr int NITEMS = I_IN;
    for (int it = gw; it < NITEMS; it += NGW) {
        int r = it;
        if (r < I_IN) { const int n0_ = 32 * (r % ((DIN + 31) / 32));
            if (n0_ < GATE_COL0) p0_transpose_item(w_in, D, DIN, (bf16_t*)(ws + WS_WIN), scr, r, lane_, DestWin());
            if (n0_ + 31 >= GATE_COL0) p0_transpose_item_f8(w_in, D, DIN, ws + WS_WIN8, scr, r, lane_, DestWin8());
            continue; } r -= I_IN;
    }
    {
        constexpr int J0 = 176, J1 = J0 + 240, J2 = J1 + 4 * 96, J3 = J2 + 96;
        for (int j = gw; j < J3; j += NGW) {
            if (j < J0) { int s = j; int slot = s < 32 ? 32 + s : (s < 32 + 48 ? 80 + (s - 32) : 160 + (s - 80)); zero_row_bf16((bf16_t*)(ws + WS_WIN) + (size_t)(44 * 256 + slot) * D, D, lane_); }
            else if (j < J1) { zero_row_bf16((bf16_t*)(ws + WS_HN) + (size_t)(NX + NMETA + (j - J0)) * D, D, lane_); }
            else if (j < J2) { const int q = j - J1, which = q / 96, rr = q % 96, b = rr / 48, p = T + rr % 48;
                const size_t base = which == 0 ? WS_KA : which == 1 ? WS_VA : which == 2 ? WS_KB : WS_VB;
                zero_row_bf16((bf16_t*)(ws + base) + ((size_t)b * TP + p) * 1024, 1024, lane_); }
            else { const int rr = j - J2, b = rr / 48, p = T + rr % 48; zero_row_bf16((bf16_t*)(ws + WS_KI) + ((size_t)b * TP + p) * 64, 64, lane_); }
        }
    }
    {
        const int gt = gw * 64 + lane_, NGT = NGW * 64;
        f32x2* rope = (f32x2*)(ws + WS_ROPE); f32x2* ropei = (f32x2*)(ws + WS_ROPEI);
        for (int i = gt; i < T * 64; i += NGT) { const int pos = i >> 6, fi = i & 63; const double ang = (double)pos * pow(10000.0, -(double)fi / 64.0); rope[i] = (f32x2){(float)cos(ang), (float)sin(ang)}; }
        for (int i = gt; i < T * 32; i += NGT) { const int pos = i >> 5, fi = i & 31; const double ang = (double)pos * pow(10000.0, -(double)fi / 32.0); ropei[i] = (f32x2){(float)cos(ang), (float)sin(ang)}; }
        bf16_t* wrh = (bf16_t*)(ws + WS_WR); bf16_t* wrl = wrh + NE * D;
        for (int i = gt; i < NE * D; i += NGT) { const int e = i / D, k = i % D; const float v = g_ffn[k] * w_router[(size_t)k * NE + e]; const unsigned h = f2bf(v); const float hv = __uint_as_float(h << 16);
            const int s_ = k >> 5, ln_ = 16 * ((k >> 3) & 3) + (e & 15), f_ = 2 * (e >> 4); const size_t o_ = ((size_t)(s_ * 4 + f_) * 64 + ln_) * 8 + (k & 7);
            wrh[o_] = (bf16_t)h; wrh[o_ + 512] = (bf16_t)f2bf(v - hv); }
    }
    for (int r = gw; r < NX + NMETA; r += NGW) {
        const float* src = r < NX ? x + (size_t)r * D : meta + (size_t)(r - NX) * D;
        const GAS f32x4* xr = (const GAS f32x4*)src + lane_; const GAS f32x4* gr = (const GAS f32x4*)g_mix + lane_;
        f32x4 v[8]; float s = 0.f;
#pragma unroll
        for (int j = 0; j < 8; ++j) { v[j] = xr[64 * j]; s += (v[j].x * v[j].x + v[j].y * v[j].y) + (v[j].z * v[j].z + v[j].w * v[j].w); }
        const float rs = 1.0f / sqrtf(wave_sum(s) * (1.f / D) + EPS);
        GAS u32x2* o8 = (GAS u32x2*)((bf16_t*)(ws + WS_HN) + (size_t)r * D) + lane_;
        GAS unsigned* o4 = (GAS unsigned*)(ws + WS_HN8 + (size_t)r * D) + lane_;
#pragma unroll
        for (int j = 0; j < 8; ++j) { const f32x4 g = gr[64 * j]; const float y0 = v[j].x * rs * g.x, y1 = v[j].y * rs * g.y, y2 = v[j].z * rs * g.z, y3 = v[j].w * rs * g.w;
            u32x2 w; w.x = cvt_pk_bf16(y0, y1); w.y = cvt_pk_bf16(y2, y3); o8[64 * j] = w; o4[64 * j] = cvt4_fp8(y0, y1, y2, y3); }
    }
}

struct EpiInProj {
    unsigned char* ws; float sc;
    template <int MODE>
    __device__ __forceinline__ void store_tile(const f32x4 (&acc)[2][2][4][2], bf16_t* dst, int ld, int colbase, size_t rowbase, int nvalid, int pos0, size_t dupoff, int wr, int wc, int fr, int fq) const {
        const f32x2* rope = (const f32x2*)(ws + WS_ROPE); const f32x2* ropei = (const f32x2*)(ws + WS_ROPEI);
#pragma unroll
        for (int ai = 0; ai < 2; ++ai)
#pragma unroll
            for (int m = 0; m < 4; ++m) {
                const int tr = ai * HALF + wr * 64 + m * 16 + fr;
                if (tr < nvalid) {
                    bf16_t* rowp = dst + (rowbase + tr) * (size_t)ld + colbase;
                    if (MODE == 0 || MODE == 1) {
#pragma unroll
                        for (int bj = 0; bj < 2; ++bj) { f32x4 v0 = acc[ai][bj][m][0] * sc, v1 = acc[ai][bj][m][1] * sc;
                            if (MODE == 1) {
#pragma unroll
                                for (int j = 0; j < 4; ++j) { v0[j] = __builtin_amdgcn_rcpf(1.f + __builtin_amdgcn_exp2f(-1.4426950408889634f * v0[j])); v1[j] = __builtin_amdgcn_rcpf(1.f + __builtin_amdgcn_exp2f(-1.4426950408889634f * v1[j])); } }
                            u32x4 w; w.x = cvt_pk_bf16(v0[0], v0[1]); w.y = cvt_pk_bf16(v0[2], v0[3]); w.z = cvt_pk_bf16(v1[0], v1[1]); w.w = cvt_pk_bf16(v1[2], v1[3]);
                            *(u32x4*)(rowp + bj * HALF + wc * 32 + 8 * fq) = w; if (dupoff) *(u32x4*)(rowp + dupoff + bj * HALF + wc * 32 + 8 * fq) = w; }
                    } else {
                        const int pos = pos0 + tr;
                        const int i0 = MODE == 2 ? (wc & 1) * 32 + 8 * fq : 8 * fq;
                        const int col = MODE == 2 ? (wc >> 1) * 128 + i0 : wc * 64 + i0;
                        const int hw = MODE == 2 ? 64 : 32;
                        const f32x4* tp = (const f32x4*)((MODE == 2 ? rope + (size_t)pos * 64 : ropei + (size_t)pos * 32) + i0);
                        const f32x4 t0 = tp[0], t1 = tp[1], t2 = tp[2], t3 = tp[3];
                        const f32x4 a0 = acc[ai][0][m][0], a1 = acc[ai][0][m][1], b0 = acc[ai][1][m][0], b1 = acc[ai][1][m][1];
                        float y1[8], y2[8];
                        y1[0] = a0[0] * t0[0] - b0[0] * t0[1]; y2[0] = b0[0] * t0[0] + a0[0] * t0[1];
                        y1[1] = a0[1] * t0[2] - b0[1] * t0[3]; y2[1] = b0[1] * t0[2] + a0[1] * t0[3];
                        y1[2] = a0[2] * t1[0] - b0[2] * t1[1]; y2[2] = b0[2] * t1[0] + a0[2] * t1[1];
                        y1[3] = a0[3] * t1[2] - b0[3] * t1[3]; y2[3] = b0[3] * t1[2] + a0[3] * t1[3];
                        y1[4] = a1[0] * t2[0] - b1[0] * t2[1]; y2[4] = b1[0] * t2[0] + a1[0] * t2[1];
                        y1[5] = a1[1] * t2[2] - b1[1] * t2[3]; y2[5] = b1[1] * t2[2] + a1[1] * t2[3];
                        y1[6] = a1[2] * t3[0] - b1[2] * t3[1]; y2[6] = b1[2] * t3[0] + a1[2] * t3[1];
                        y1[7] = a1[3] * t3[2] - b1[3] * t3[3]; y2[7] = b1[3] * t3[2] + a1[3] * t3[3];
                        u32x4 w1, w2; w1.x = cvt_pk_bf16(y1[0], y1[1]); w1.y = cvt_pk_bf16(y1[2], y1[3]); w1.z = cvt_pk_bf16(y1[4], y1[5]); w1.w = cvt_pk_bf16(y1[6], y1[7]);
                        w2.x = cvt_pk_bf16(y2[0], y2[1]); w2.y = cvt_pk_bf16(y2[2], y2[3]); w2.z = cvt_pk_bf16(y2[4], y2[5]); w2.w = cvt_pk_bf16(y2[6], y2[7]);
                        *(u32x4*)(rowp + col) = w1; *(u32x4*)(rowp + col + hw) = w2; if (dupoff) { *(u32x4*)(rowp + dupoff + col) = w1; *(u32x4*)(rowp + dupoff + col + hw) = w2; }
                    }
                }
                asm volatile("" ::: "memory");
            }
    }
    __device__ __forceinline__ void operator()(const f32x4 (&acc)[2][2][4][2], const Unit& u, int wr, int wc, int fr, int fq) const {
        const int pn = u.pn, pm = u.pm;
        const int sec = pn < 28 ? (pn >> 2) : (pn < 36 ? 7 : (pn < 44 ? 8 : 9));
        const int mode = (sec == 2 || sec == 6) ? 0 : ((sec == 7 || sec == 8) ? 1 : ((sec == 3 || sec == 9) ? 3 : 2));
        const int kt = (sec == 1 || sec == 2 || sec == 5 || sec == 6 || sec == 9) ? 1 : 0;
        const int ld = (sec == 7 || sec == 8) ? 2048 : (sec == 9 ? 64 : 1024);
        const int colbase = sec < 7 ? (pn & 3) * 256 : (sec == 7 ? (pn - 28) * 256 : (sec == 8 ? (pn - 36) * 256 : 0));
        const size_t off = sec == 0 ? WS_QA : sec == 1 ? WS_KA : sec == 2 ? WS_VA : sec == 3 ? WS_QI : sec == 4 ? WS_QB : sec == 5 ? WS_KB : sec == 6 ? WS_VB : sec == 7 ? WS_GA : sec == 8 ? WS_GB : WS_KI;
        if (sec == 9 && pm < 64 && wc == 2 && fq < 2) {
            float* WI = (float*)(ws + WS_WI);
#pragma unroll
            for (int ai = 0; ai < 2; ++ai)
#pragma unroll
                for (int m = 0; m < 4; ++m) { const int r = pm * 256 + ai * HALF + wr * 64 + m * 16 + fr;
                    *(f32x4*)(WI + (size_t)r * 16 + 8 * fq) = acc[ai][0][m][0] * (1.0f / 32.0f); *(f32x4*)(WI + (size_t)r * 16 + 8 * fq + 4) = acc[ai][0][m][1] * (1.0f / 32.0f); }
        }
        const bool meta = pm >= 64;
        const bool active = (sec != 9 || wc == 0) && (kt != 0 || !meta);
        bf16_t* dst = (bf16_t*)(ws + off);
        const int pos0 = meta ? 0 : NMETA + (pm & 31) * 256;
        const int nvalid = active ? (meta ? NMETA : 256) : 0;
        const size_t rowbase = meta ? (size_t)0 : (kt ? (size_t)(pm >> 5) * TP + pos0 : (size_t)pm * 256);
        const size_t dupoff = meta ? (size_t)TP * ld : (size_t)0;
        if (mode == 0) store_tile<0>(acc, dst, ld, colbase, rowbase, nvalid, pos0, dupoff, wr, wc, fr, fq);
        else if (mode == 1) store_tile<1>(acc, dst, ld, colbase, rowbase, nvalid, pos0, dupoff, wr, wc, fr, fq);
        else if (mode == 2) store_tile<2>(acc, dst, ld, colbase, rowbase, nvalid, pos0, dupoff, wr, wc, fr, fq);
        else store_tile<3>(acc, dst, ld, colbase, rowbase, nvalid, pos0, dupoff, wr, wc, fr, fq);
    }
};


struct EpiUp {
    static constexpr bool HAS_MID = true;
    const bf16_t* GA; const bf16_t* GB; unsigned char* MG; float msc, esc;
    __device__ __forceinline__ void mid(f32x4 (&acc)[2][2][4][2], const Unit& u, int wr, int wc, int fr, int fq) const {
        asm volatile("" : "+v"(fr), "+v"(fq));
#pragma unroll
        for (int ai = 0; ai < 2; ++ai)
#pragma unroll
            for (int m = 0; m < 4; ++m) { const size_t ro = (size_t)(u.pm * 256 + ai * HALF + wr * 64 + m * 16 + fr) * D + u.pn * 256 + wc * 32 + 8 * fq;
#pragma unroll
                for (int bj = 0; bj < 2; ++bj) { const u32x4 a = *(const u32x4*)(GA + ro + bj * HALF), b = *(const u32x4*)(GB + ro + bj * HALF);
                    f32x4& v0 = acc[ai][bj][m][0]; f32x4& v1 = acc[ai][bj][m][1];
                    v0[0] *= msc * __uint_as_float(a.x << 16) * __builtin_amdgcn_rcpf(__uint_as_float(b.x << 16)); v0[1] *= msc * __uint_as_float(a.x & 0xffff0000u) * __builtin_amdgcn_rcpf(__uint_as_float(b.x & 0xffff0000u));
                    v0[2] *= msc * __uint_as_float(a.y << 16) * __builtin_amdgcn_rcpf(__uint_as_float(b.y << 16)); v0[3] *= msc * __uint_as_float(a.y & 0xffff0000u) * __builtin_amdgcn_rcpf(__uint_as_float(b.y & 0xffff0000u));
                    v1[0] *= msc * __uint_as_float(a.z << 16) * __builtin_amdgcn_rcpf(__uint_as_float(b.z << 16)); v1[1] *= msc * __uint_as_float(a.z & 0xffff0000u) * __builtin_amdgcn_rcpf(__uint_as_float(b.z & 0xffff0000u));
                    v1[2] *= msc * __uint_as_float(a.w << 16) * __builtin_amdgcn_rcpf(__uint_as_float(b.w << 16)); v1[3] *= msc * __uint_as_float(a.w & 0xffff0000u) * __builtin_amdgcn_rcpf(__uint_as_float(b.w & 0xffff0000u)); }
                asm volatile("" ::: "memory"); }
    }
    __device__ __forceinline__ void operator()(const f32x4 (&acc)[2][2][4][2], const Unit& u, int wr, int wc, int fr, int fq) const {
#pragma unroll
        for (int ai = 0; ai < 2; ++ai)
#pragma unroll
            for (int m = 0; m < 4; ++m) { const size_t ro = (size_t)(u.pm * 256 + ai * HALF + wr * 64 + m * 16 + fr) * D + u.pn * 256 + wc * 32 + 8 * fq;
#pragma unroll
                for (int bj = 0; bj < 2; ++bj) { const u32x4 g = *(const u32x4*)(GB + ro + bj * HALF);
                    const f32x4 v0 = acc[ai][bj][m][0] * esc, v1 = acc[ai][bj][m][1] * esc;
                    u32x2 w;
                    w.x = cvt4_fp8(v0[0] * __uint_as_float(g.x << 16), v0[1] * __uint_as_float(g.x & 0xffff0000u), v0[2] * __uint_as_float(g.y << 16), v0[3] * __uint_as_float(g.y & 0xffff0000u));
                    w.y = cvt4_fp8(v1[0] * __uint_as_float(g.z << 16), v1[1] * __uint_as_float(g.z & 0xffff0000u), v1[2] * __uint_as_float(g.w << 16), v1[3] * __uint_as_float(g.w & 0xffff0000u));
                    *(u32x2*)(MG + ro + bj * HALF) = w; }
                asm volatile("" ::: "memory"); }
    }
};
struct EpiOut {
    const float* X; bf16_t* H1; float sc;
    __device__ __forceinline__ void operator()(const f32x4 (&acc)[2][2][4][2], const Unit& u, int wr, int wc, int fr, int fq) const {
#pragma unroll
        for (int ai = 0; ai < 2; ++ai)
#pragma unroll
            for (int m = 0; m < 4; ++m) { const size_t ro = (size_t)(u.pm * 256 + ai * HALF + wr * 64 + m * 16 + fr) * D + u.pn * 256 + wc * 32 + 8 * fq;
#pragma unroll
                for (int bj = 0; bj < 2; ++bj) { const f32x4 x0 = *(const f32x4*)(X + ro + bj * HALF), x1 = *(const f32x4*)(X + ro + bj * HALF + 4);
                    const f32x4 v0 = x0 + acc[ai][bj][m][0] * sc, v1 = x1 + acc[ai][bj][m][1] * sc;
                    u32x4 w; w.x = cvt_pk_bf16(v0[0], v0[1]); w.y = cvt_pk_bf16(v0[2], v0[3]); w.z = cvt_pk_bf16(v1[0], v1[1]); w.w = cvt_pk_bf16(v1[2], v1[3]);
                    *(u32x4*)(H1 + ro + bj * HALF) = w; }
                asm volatile("" ::: "memory"); }
    }
};

__device__ __forceinline__ void moe_tables(Frame& F) {
    volatile LAS int* tb = (volatile LAS int*)(F.lds + MOE_TB_OFF); volatile LAS int* cnt = (volatile LAS int*)(F.lds + MOE_CNT_OFF);
    const int tid_ = F.wave * 64 + fresh_lane();
    __syncthreads();
    if (tid_ < NE) cnt[tid_] = (int)__hip_atomic_load(F.ctl + CW_CNT + 64 * tid_, __ATOMIC_RELAXED, __HIP_MEMORY_SCOPE_AGENT);
    __syncthreads();
    if (tid_ == 0) { int run = 0; for (int e = 0; e < NE; ++e) { tb[e] = run; run += (cnt[e] + 255) >> 8; } tb[NE] = run < MAXT ? run : MAXT; }
    __syncthreads();
}
struct MoeOrder {
    int G, c, nPN; const volatile LAS int* tb;
    __device__ bool next(int i, Unit& u) const {
        const int L = i * G + c, TT = tb[NE]; if (L >= TT * nPN) return false;
        const int t = L / nPN; u.pm = t; u.pn = L - t * nPN; int e = 0;
        for (int j = 1; j < NE; ++j) e += (tb[j] <= t) ? 1 : 0;
        u.ex = e; return true;
    }
};
struct MoeAB1 {
    const char* HB; const char* W1T; const int* lists; const volatile LAS int* tb; const volatile LAS int* cnt;
    __device__ __forceinline__ const char* a_base(const Unit&) const { return HB; }
    __device__ __forceinline__ const char* b_base(const Unit& u) const { return W1T + ((size_t)u.ex * 4096 + (size_t)u.pn * 256) * D; }
    __device__ __forceinline__ void a_voff(const Unit& u, const int (&R)[2], const int (&C)[2], unsigned (&v)[4]) const {
        const int base = (u.pm - tb[u.ex]) * 256, n = cnt[u.ex]; const int* le = lists + (size_t)u.ex * MAXL;
#pragma unroll
        for (int h = 0; h < 2; ++h)
#pragma unroll
            for (int i = 0; i < 2; ++i) { const int row = base + R[i] + HALF * h; const int tok = le[row < n ? row : 0]; v[2 * h + i] = (unsigned)(tok * D + 2 * C[i]); }
    }
};
struct MoeAB2 {
    const char* Gb; const char* W2T;
    __device__ __forceinline__ const char* a_base(const Unit& u) const { return Gb + (size_t)u.pm * 256 * DFF; }
    __device__ __forceinline__ const char* b_base(const Unit& u) const { return W2T + ((size_t)u.ex * D + (size_t)u.pn * 256) * DFF; }
    __device__ __forceinline__ void a_voff(const Unit&, const int (&R)[2], const int (&C)[2], unsigned (&v)[4]) const {
#pragma unroll
        for (int i = 0; i < 2; ++i) { v[i] = (unsigned)(R[i] * DFF + 2 * C[i]); v[2 + i] = (unsigned)((R[i] + HALF) * DFF + 2 * C[i]); } }
};
struct EpiMoe1 {
    const float* b1; unsigned char* G;
    __device__ __forceinline__ void operator()(const f32x4 (&acc)[2][2][4][2], const Unit& u, int wr, int wc, int fr, int fq) const {
        const int col0 = u.pn * 256 + wc * 32 + 8 * fq; const float* bp = b1 + (size_t)u.ex * 4096 + col0;
        const f32x4 ba0 = *(const f32x4*)(bp), ba1 = *(const f32x4*)(bp + 4), bb0 = *(const f32x4*)(bp + HALF), bb1 = *(const f32x4*)(bp + HALF + 4);
#pragma unroll
        for (int ai = 0; ai < 2; ++ai)
#pragma unroll
            for (int m = 0; m < 4; ++m) { unsigned char* rowp = G + (size_t)(u.pm * 256 + ai * HALF + wr * 64 + m * 16 + fr) * DFF + (col0 >> 1);
#pragma unroll
                for (int bj = 0; bj < 2; ++bj) { const f32x4 v0 = acc[ai][bj][m][0] * F8_WINV + (bj ? bb0 : ba0), v1 = acc[ai][bj][m][1] * F8_WINV + (bj ? bb1 : ba1);
                    float o[4];
                    const float ga[4] = {v0[0], v0[2], v1[0], v1[2]}, li[4] = {v0[1], v0[3], v1[1], v1[3]};
#pragma unroll
                    for (int j = 0; j < 4; ++j) { const float a = fminf(ga[j], 7.0f), l = fminf(fmaxf(li[j], -7.0f), 7.0f);
                        const float sg = __builtin_amdgcn_rcpf(1.0f + __builtin_amdgcn_exp2f(-1.702f * 1.4426950408889634f * a)); o[j] = (a * sg) * (l + 1.0f); }
                    *(unsigned*)(rowp + bj * (HALF / 2)) = cvt4_fp8(o[0], o[1], o[2], o[3]); }
                asm volatile("" ::: "memory"); }
    }
};
struct EpiMoe2 {
    const float* b2; bf16_t* Y;
    __device__ __forceinline__ void operator()(const f32x4 (&acc)[2][2][4][2], const Unit& u, int wr, int wc, int fr, int fq) const {
        const int col0 = u.pn * 256 + wc * 32 + 8 * fq; const float* bp = b2 + (size_t)u.ex * D + col0;
        const f32x4 ba0 = *(const f32x4*)(bp), ba1 = *(const f32x4*)(bp + 4), bb0 = *(const f32x4*)(bp + HALF), bb1 = *(const f32x4*)(bp + HALF + 4);
#pragma unroll
        for (int ai = 0; ai < 2; ++ai)
#pragma unroll
            for (int m = 0; m < 4; ++m) { bf16_t* rowp = Y + (size_t)(u.pm * 256 + ai * HALF + wr * 64 + m * 16 + fr) * D + col0;
#pragma unroll
                for (int bj = 0; bj < 2; ++bj) { const f32x4 v0 = acc[ai][bj][m][0] * F8_WINV + (bj ? bb0 : ba0), v1 = acc[ai][bj][m][1] * F8_WINV + (bj ? bb1 : ba1);
                    u32x4 w; w.x = cvt_pk_bf16(v0[0], v0[1]); w.y = cvt_pk_bf16(v0[2], v0[3]); w.z = cvt_pk_bf16(v1[0], v1[1]); w.w = cvt_pk_bf16(v1[2], v1[3]);
                    *(u32x4*)(rowp + bj * HALF) = w; }
                asm volatile("" ::: "memory"); }
    }
};

typedef float f32x4v __attribute__((ext_vector_type(4)));
__device__ __forceinline__ void router_phase(Frame& F) {
    const int gw = F.vcu * NWAVES + F.wave, NGW = F.G * NWAVES, lane = fresh_lane(), r = lane & 15, q = lane >> 4;
    const bf16_t* H1 = (const bf16_t*)(F.ws + WS_H1); bf16_t* HB = (bf16_t*)(F.ws + WS_HB);
    const bf16_t* wrh = (const bf16_t*)(F.ws + WS_WR); const bf16_t* wrl = wrh + NE * D;
    const float* g_ffn = F.in[12]; const float* b_router = F.in[14];
    float* GATE = (float*)(F.ws + WS_GATE); int* SEI = (int*)(F.ws + WS_SEI); int* LIST = (int*)(F.ws + WS_LIST);
    LAS float* lg = (LAS float*)(F.lds + RING_OFF + F.wave * 16384);
    for (int tile = (F.wave < 4 ? F.vcu * 4 + F.wave : NX), tstep = F.G * 4; tile < NX / 16; tile += tstep) {
        const int lr = lane >> 4, lc = lane & 15;
        LAS unsigned char* stg = (LAS unsigned char*)lg + 4096;
        LAS float* rsb = lg + 576;
        const bf16_t* hrow = H1 + (size_t)(tile * 16 + lr) * D + 8 * lc;
        f32x4v c0 = {0.f, 0.f, 0.f, 0.f}, c1 = {0.f, 0.f, 0.f, 0.f}; float ssj[4] = {0.f, 0.f, 0.f, 0.f};
#pragma unroll 2
        for (int kb = 0; kb < D / 128; ++kb) {
            u32x4 t[4];
#pragma unroll
            for (int j = 0; j < 4; ++j) t[j] = *(const u32x4*)(hrow + (size_t)(4 * j) * D + 128 * kb);
#pragma unroll
            for (int j = 0; j < 4; ++j) { const u32x4 hw = t[j];
                const float a0 = __uint_as_float(hw.x << 16), a1 = __uint_as_float(hw.x & 0xffff0000u), a2 = __uint_as_float(hw.y << 16), a3 = __uint_as_float(hw.y & 0xffff0000u);
                const float a4 = __uint_as_float(hw.z << 16), a5 = __uint_as_float(hw.z & 0xffff0000u), a6 = __uint_as_float(hw.w << 16), a7 = __uint_as_float(hw.w & 0xffff0000u);
                ssj[j] += (a0 * a0 + a1 * a1) + (a2 * a2 + a3 * a3) + (a4 * a4 + a5 * a5) + (a6 * a6 + a7 * a7);
                *(LAS u32x4*)(stg + (lr + 4 * j) * 272 + 16 * lc) = hw; }
            LDS_WAIT(); asm volatile("" ::: "memory");
#pragma unroll
            for (int ks = 0; ks < 4; ++ks) {
                const bf16x8 ah = *(const LAS bf16x8*)(stg + r * 272 + 64 * ks + 16 * q);
                const bf16_t* wf = wrh + ((size_t)((4 * kb + ks) * 4) * 64 + lane) * 8;
                const bf16x8 bh0 = *(const bf16x8*)(wf), bl0 = *(const bf16x8*)(wf + 512), bh1 = *(const bf16x8*)(wf + 1024), bl1 = *(const bf16x8*)(wf + 1536);
                c0 = __builtin_amdgcn_mfma_f32_16x16x32_bf16(ah, bh0, c0, 0, 0, 0); c0 = __builtin_amdgcn_mfma_f32_16x16x32_bf16(ah, bl0, c0, 0, 0, 0);
                c1 = __builtin_amdgcn_mfma_f32_16x16x32_bf16(ah, bh1, c1, 0, 0, 0); c1 = __builtin_amdgcn_mfma_f32_16x16x32_bf16(ah, bl1, c1, 0, 0, 0);
            }
            LDS_WAIT(); asm volatile("" ::: "memory");
        }
#pragma unroll
        for (int j = 0; j < 4; ++j) { float v = ssj[j]; v += __shfl_xor(v, 1); v += __shfl_xor(v, 2); v += __shfl_xor(v, 4); v += __shfl_xor(v, 8);
            if (lc == 0) rsb[lr + 4 * j] = 1.0f / sqrtf(v * (1.0f / D) + EPS); }
        LDS_WAIT(); asm volatile("" ::: "memory");
        {
            unsigned char* ob = (unsigned char*)HB + (size_t)(tile * 16 + lr) * D + 8 * lc; const float* gp = g_ffn + 8 * lc;
            float rsr[4];
#pragma unroll
            for (int j = 0; j < 4; ++j) rsr[j] = rsb[lr + 4 * j];
#pragma unroll 2
            for (int kb = 0; kb < D / 128; ++kb) { const f32x4 g0 = *(const f32x4*)(gp + 128 * kb), g1 = *(const f32x4*)(gp + 128 * kb + 4);
#pragma unroll
                for (int j = 0; j < 4; ++j) { const u32x4 hw = *(const u32x4*)(hrow + (size_t)(4 * j) * D + 128 * kb); const float rs_ = rsr[j];
                    u32x2 w; w.x = cvt4_fp8(__uint_as_float(hw.x << 16) * rs_ * g0[0], __uint_as_float(hw.x & 0xffff0000u) * rs_ * g0[1], __uint_as_float(hw.y << 16) * rs_ * g0[2], __uint_as_float(hw.y & 0xffff0000u) * rs_ * g0[3]);
                    w.y = cvt4_fp8(__uint_as_float(hw.z << 16) * rs_ * g1[0], __uint_as_float(hw.z & 0xffff0000u) * rs_ * g1[1], __uint_as_float(hw.w << 16) * rs_ * g1[2], __uint_as_float(hw.w & 0xffff0000u) * rs_ * g1[3]);
                    *(u32x2*)(ob + (size_t)(4 * j) * D + 128 * kb) = w; } }
        }
#pragma unroll
        for (int i = 0; i < 4; ++i) { const float rsi = rsb[4 * q + i]; lg[(4 * q + i) * 33 + r] = c0[i] * rsi + b_router[r]; lg[(4 * q + i) * 33 + 16 + r] = c1[i] * rsi + b_router[16 + r]; }
        LDS_WAIT(); asm volatile("" ::: "memory");
        if (lane < 16) {
            const int trow = tile * 16 + lane; float l[NE];
#pragma unroll
            for (int e = 0; e < NE; ++e) l[e] = lg[lane * 33 + e];
            int i0 = -1, i1 = -1, i2 = -1, i3 = -1; float v0 = 0.f, v1 = 0.f, v2 = 0.f, v3 = 0.f;
#pragma unroll
            for (int k = 0; k < 4; ++k) { int bi = -1; float bv = 0.f;
#pragma unroll
                for (int e = 0; e < NE; ++e) { const bool used = (e == i0) || (e == i1) || (e == i2) || (e == i3); if (!used && (bi < 0 || l[e] > bv)) { bi = e; bv = l[e]; } }
                if (k == 0) { i0 = bi; v0 = bv; } else if (k == 1) { i1 = bi; v1 = bv; } else if (k == 2) { i2 = bi; v2 = bv; } else { i3 = bi; v3 = bv; } }
            const float p1 = __expf(v1 - v0), p2 = __expf(v2 - v0), p3 = __expf(v3 - v0), inv = 1.0f / (1.0f + p1 + p2 + p3);
            *(f32x4*)(GATE + (size_t)trow * 4) = (f32x4){inv, p1 * inv, p2 * inv, p3 * inv};
            const int o0 = (int)atomicAdd(F.ctl + CW_CNT + 64 * i0, 1u), o1 = (int)atomicAdd(F.ctl + CW_CNT + 64 * i1, 1u), o2 = (int)atomicAdd(F.ctl + CW_CNT + 64 * i2, 1u), o3 = (int)atomicAdd(F.ctl + CW_CNT + 64 * i3, 1u);
            LIST[(size_t)i0 * MAXL + o0] = trow; LIST[(size_t)i1 * MAXL + o1] = trow; LIST[(size_t)i2 * MAXL + o2] = trow; LIST[(size_t)i3 * MAXL + o3] = trow;
            typedef int i32x4 __attribute__((ext_vector_type(4)));
            *(i32x4*)(SEI + (size_t)trow * 4) = (i32x4){(i0 << 16) | o0, (i1 << 16) | o1, (i2 << 16) | o2, (i3 << 16) | o3};
        }
        LDS_WAIT(); asm volatile("" ::: "memory");
    }
}
__device__ __forceinline__ void final_phase(Frame& F) {
    const int lane_ = fresh_lane();
    const int gw = F.vcu * NWAVES + F.wave, NGW = F.G * NWAVES;
    const bf16_t* H1 = (const bf16_t*)(F.ws + WS_H1); const bf16_t* Y = (const bf16_t*)(F.ws + WS_Y); const float* GATE = (const float*)(F.ws + WS_GATE); const int* SEI = (const int*)(F.ws + WS_SEI);
    const float* g_fin = F.in[19]; volatile LAS int* tb = (volatile LAS int*)(F.lds + MOE_TB_OFF);
    for (int t = gw; t < NX; t += NGW) {
        const GAS u32x2* hr = (const GAS u32x2*)(H1 + (size_t)t * D) + lane_;
        f32x4 v[8];
#pragma unroll
        for (int j = 0; j < 8; ++j) { const u32x2 w = hr[64 * j]; v[j] = (f32x4){__uint_as_float(w.x << 16), __uint_as_float(w.x & 0xffff0000u), __uint_as_float(w.y << 16), __uint_as_float(w.y & 0xffff0000u)}; }
        const f32x4 gt = *(const f32x4*)(GATE + (size_t)t * 4);
        typedef int i32x4 __attribute__((ext_vector_type(4)));
        const i32x4 se = *(const i32x4*)(SEI + (size_t)t * 4);
#pragma unroll
        for (int k = 0; k < 4; ++k) { const int e = se[k] >> 16, i = se[k] & 0xffff; const size_t slot = (size_t)tb[e] * 256 + i; const float gk = gt[k];
            const GAS u32x2* yr = (const GAS u32x2*)(Y + slot * D) + lane_;
#pragma unroll
            for (int j = 0; j < 8; ++j) { const u32x2 w = yr[64 * j];
                v[j][0] += gk * __uint_as_float(w.x << 16); v[j][1] += gk * __uint_as_float(w.x & 0xffff0000u); v[j][2] += gk * __uint_as_float(w.y << 16); v[j][3] += gk * __uint_as_float(w.y & 0xffff0000u); } }
        float s = 0.f;
#pragma unroll
        for (int j = 0; j < 8; ++j) s += (v[j][0] * v[j][0] + v[j][1] * v[j][1]) + (v[j][2] * v[j][2] + v[j][3] * v[j][3]);
        float rs = 1.0f / sqrtf(wave_sum(s) * (1.0f / D) + EPS);
        GAS f32x4* orow = (GAS f32x4*)(F.out + (size_t)t * D) + lane_; const GAS f32x4* gr = (const GAS f32x4*)g_fin + lane_;
#pragma unroll
        for (int j = 0; j < 8; ++j) { const f32x4 g = gr[64 * j]; orow[64 * j] = v[j] * rs * g; }
    }
}

namespace at {
typedef float f32x16 __attribute__((ext_vector_type(16)));
typedef short s16x4 __attribute__((ext_vector_type(4)));
constexpr int NW = 8, QBLK = 32, KVBLK = 64, QB = NW * QBLK, HD = 128;
constexpr int SHM_V = KVBLK * HD * 2, SHM_K = KVBLK * HD * 2;
constexpr int ATT_LDS = 2 * SHM_V + 2 * SHM_K + NW * 64 * 4;
constexpr int LDQ = 1024, LDKV = 1024;
constexpr int NWM = 129;
constexpr float SCALE = 0.08838834764831845f, THR = 8.f;
#define KSWZ(row, colB) ((row) * 256 + ((colB) ^ (((row) & 7) << 4)))
#define SBAR() __builtin_amdgcn_sched_barrier(0)
__device__ __forceinline__ int v_st(int k, int c) { const int kk = (k & ~0xC) | ((k & 4) << 1) | ((k & 8) >> 1); return ((kk >> 3) * 4 + (c >> 5)) * 512 + ((kk & 7) * 32 + (c & 31)) * 2; }
__device__ __forceinline__ int v_rd_base(int lane) { return ((lane & 3) << 3) | (((lane >> 2) & 3) << 6) | (((lane >> 4) & 1) << 5) | (((lane >> 5) & 1) << 8); }
constexpr int v_rd_off(int d0, int ks, int half) { return d0 * 512 + ks * 4096 + half * 2048; }
__device__ __forceinline__ int crow(int r, int hi) { return (r & 3) + 8 * (r >> 2) + 4 * hi; }
__device__ __forceinline__ bf16x8 load8(const bf16_t* p) { return *reinterpret_cast<const bf16x8*>(p); }
__device__ __forceinline__ float xor1f(float v) { return __int_as_float(__builtin_amdgcn_update_dpp(0, __float_as_int(v), 0xB1, 0xF, 0xF, true)); }
__device__ __forceinline__ void mask_tile(f32x16& p0, f32x16& p1, int dq) {
    const float NEG = -__builtin_inff();
#pragma unroll
    for (int r = 0; r < 16; ++r) { const int c = (r & 3) + 8 * (r >> 2); if (dq - c < 0) p0[r] = NEG; if (dq - c - 32 < 0) p1[r] = NEG; }
}
__device__ __forceinline__ void mask_bits(f32x16& p0, f32x16& p1, unsigned long long w, int hi) {
    const unsigned long long wsft = w >> (4 * hi); const int lo = (int)(unsigned)wsft, hb = (int)(unsigned)(wsft >> 32); const int NEGB = (int)0xFF800000u;
#pragma unroll
    for (int r = 0; r < 16; ++r) { const int c = (r & 3) + 8 * (r >> 2);
        const int t0 = __builtin_amdgcn_sbfe(lo, c, 1), t1 = __builtin_amdgcn_sbfe(hb, c, 1);
        p0[r] = __int_as_float((__float_as_int(p0[r]) & t0) | (~t0 & NEGB)); p1[r] = __int_as_float((__float_as_int(p1[r]) & t1) | (~t1 & NEGB)); }
}
__device__ __forceinline__ void partialSM(f32x16& p0, f32x16& p1, float& m_reg, float& mn, float& alpha) {
    float pmax = p0[0];
#pragma unroll
    for (int r = 1; r < 16; ++r) pmax = fmaxf(pmax, p0[r]);
#pragma unroll
    for (int r = 0; r < 16; ++r) pmax = fmaxf(pmax, p1[r]);
    { auto rr = __builtin_amdgcn_permlane32_swap(__float_as_uint(pmax), __float_as_uint(pmax), false, false);
      pmax = fmaxf(__uint_as_float(rr[0]), __uint_as_float(rr[1])); }
    constexpr float C2 = 1.4426950408889634f * SCALE;
    if (__builtin_expect(__all((pmax - m_reg) * SCALE <= THR), 1)) { mn = m_reg; alpha = 1.f; }
    else { mn = fmaxf(m_reg, pmax); alpha = __builtin_amdgcn_exp2f((m_reg - mn) * C2); m_reg = mn; }
    const float mnL = -mn * C2;
#pragma unroll
    for (int r = 0; r < 16; ++r) p0[r] = fmaf(p0[r], C2, mnL);
#pragma unroll
    for (int r = 0; r < 16; ++r) p1[r] = fmaf(p1[r], C2, mnL);
#pragma unroll
    for (int r = 0; r < 16; ++r) p0[r] = __builtin_amdgcn_exp2f(p0[r]);
}
__device__ __forceinline__ void finishSM(f32x16& p0, f32x16& p1, float alpha, float& l_reg, bf16x8& pa0, bf16x8& pa1, bf16x8& pa2, bf16x8& pa3) {
#pragma unroll
    for (int r = 0; r < 16; ++r) p1[r] = __builtin_amdgcn_exp2f(p1[r]);
    float ps = 0;
#pragma unroll
    for (int r = 0; r < 16; ++r) ps += p0[r];
#pragma unroll
    for (int r = 0; r < 16; ++r) ps += p1[r];
    { auto rr = __builtin_amdgcn_permlane32_swap(__float_as_uint(ps), __float_as_uint(ps), false, false);
      ps = __uint_as_float(rr[0]) + __uint_as_float(rr[1]); }
    l_reg = l_reg * alpha + ps;
#define PK4(P, B_, OUT) do { unsigned a0 = cvt_pk_bf16(P[B_+0], P[B_+1]), a1 = cvt_pk_bf16(P[B_+2], P[B_+3]);                          \
        unsigned b0 = cvt_pk_bf16(P[B_+4], P[B_+5]), b1 = cvt_pk_bf16(P[B_+6], P[B_+7]);                                             \
        auto r0 = __builtin_amdgcn_permlane32_swap(a0, b0, false, false); auto r1 = __builtin_amdgcn_permlane32_swap(a1, b1, false, false); \
        u32x4 w = {r0[0], r1[0], r0[1], r1[1]}; OUT = *reinterpret_cast<bf16x8*>(&w); } while (0)
    PK4(p0, 0, pa0); PK4(p0, 8, pa1); PK4(p1, 0, pa2); PK4(p1, 8, pa3);
#undef PK4
}
template <int KB>
__device__ __forceinline__ void qkt(f32x16& p0, f32x16& p1, const LAS char* K_lds, int r32, int hi, const bf16x8* qr) {
    p0 = f32x16{}; p1 = f32x16{};
    const LAS char* kb[4];
#pragma unroll
    for (int dd = 0; dd < 4; ++dd) kb[dd] = K_lds + KB * SHM_K + KSWZ(r32, (dd * 16 + hi * 8) * 2);
#pragma unroll
    for (int d0 = 0; d0 < 8; ++d0) { const LAS char* a = kb[d0 & 3] + (d0 >> 2) * 128;
        bf16x8 b0 = *(const LAS bf16x8*)(a);
        bf16x8 b1 = *(const LAS bf16x8*)(a + 32 * 256);
        p0 = __builtin_amdgcn_mfma_f32_32x32x16_bf16(b0, qr[d0], p0, 0, 0, 0);
        p1 = __builtin_amdgcn_mfma_f32_32x32x16_bf16(b1, qr[d0], p1, 0, 0, 0); }
}
template <int VB>
__device__ __forceinline__ void pv_tile(f32x16* o, int vb0, bf16x8 pa0, bf16x8 pa1, bf16x8 pa2, bf16x8 pa3) {
#define TRRD(dst, off) asm volatile("ds_read_b64_tr_b16 %0, %1 offset:%2" : "=&v"(dst) : "v"(vb0), "i"(off) : "memory")
#define PV_D0(d0) do { s16x4 l0, l1, l2, l3, h0, h1, h2, h3; constexpr int b_ = VB * SHM_V + v_rd_off(d0, 0, 0); \
        TRRD(l0, b_); TRRD(h0, b_ + 2048); TRRD(l1, b_ + 4096); TRRD(h1, b_ + 6144); TRRD(l2, b_ + 8192); TRRD(h2, b_ + 10240); TRRD(l3, b_ + 12288); TRRD(h3, b_ + 14336); \
        asm volatile("s_waitcnt lgkmcnt(0)" ::: "memory"); SBAR();   \
        o[d0] = __builtin_amdgcn_mfma_f32_32x32x16_bf16(pa0, (bf16x8){l0[0], l0[1], l0[2], l0[3], h0[0], h0[1], h0[2], h0[3]}, o[d0], 0, 0, 0);   \
        o[d0] = __builtin_amdgcn_mfma_f32_32x32x16_bf16(pa1, (bf16x8){l1[0], l1[1], l1[2], l1[3], h1[0], h1[1], h1[2], h1[3]}, o[d0], 0, 0, 0);   \
        o[d0] = __builtin_amdgcn_mfma_f32_32x32x16_bf16(pa2, (bf16x8){l2[0], l2[1], l2[2], l2[3], h2[0], h2[1], h2[2], h2[3]}, o[d0], 0, 0, 0);   \
        o[d0] = __builtin_amdgcn_mfma_f32_32x32x16_bf16(pa3, (bf16x8){l3[0], l3[1], l3[2], l3[3], h3[0], h3[1], h3[2], h3[3]}, o[d0], 0, 0, 0); } while (0)
    PV_D0(0); PV_D0(1); PV_D0(2); PV_D0(3);
#undef PV_D0
#undef TRRD
}
constexpr int LDO = 3072;
struct BlockRef { unsigned q, k, v, o, m; int P0; };
struct Seam { bf16x8 qr[8]; bf16x8 st_v0, st_v1, st_k0, st_k1; };
#define VMW() asm volatile("s_waitcnt vmcnt(0)" ::: "memory")
#define VMWN(n) asm volatile("s_waitcnt vmcnt(%0)" :: "i"(n) : "memory")
#define SLOAD_H(Kp, Vp, k0) do { const bf16_t* kb_ = (Kp) + (size_t)(k0) * LDKV; const bf16_t* vb_ = (Vp) + (size_t)(k0) * LDKV;              \
                         const bf16_t* kb2_ = kb_ + 32 * LDKV; const bf16_t* vb2_ = vb_ + 32 * LDKV;                                           \
                         S.st_v0 = load8(vb_ + lo0); S.st_v1 = load8(vb2_ + lo0); S.st_k0 = load8(kb_ + lo0); S.st_k1 = load8(kb2_ + lo0); } while (0)
#define SWRITE_HK(bf) do { *(LAS bf16x8*)(K_lds + (bf) * SHM_K + kws) = S.st_k0; *(LAS bf16x8*)(K_lds + (bf) * SHM_K + kws + 32 * 256) = S.st_k1; } while (0)
#define SWRITE_HV(bf) do { *(LAS bf16x8*)(V_lds + (bf) * SHM_V + vst0) = S.st_v0; *(LAS bf16x8*)(V_lds + (bf) * SHM_V + vst0 + 8192) = S.st_v1; } while (0)
#define SWRITE_H(bf) do { SWRITE_HV(bf); SWRITE_HK(bf); } while (0)
#define QLOAD(ref) do { const bf16_t* qb_ = (const bf16_t*)(wsb + (ref).q); _Pragma("unroll") for (int d0 = 0; d0 < 8; ++d0) S.qr[d0] = load8(qb_ + qlo_off + d0 * 16); } while (0)
__device__ __forceinline__ void attn_prime(const unsigned char* wsb, const BlockRef& cur, LAS char* lds, Seam& S, int wave_) {
    const int wid = wave_, lane = fresh_lane(), tid = wid * 64 + lane, r32 = lane & 31, hi = lane >> 5;
    const int sr = tid >> 4, sc = (tid & 15) * 8, kws = KSWZ(sr, sc * 2); LAS char* K_lds = lds + 2 * SHM_V;
    const unsigned lo0 = (unsigned)(sr * LDKV + sc), qlo_off = (unsigned)((wid * QBLK + r32) * LDQ + hi * 8);
    QLOAD(cur);
    SLOAD_H((const bf16_t*)(wsb + cur.k), (const bf16_t*)(wsb + cur.v), 0); VMW(); SWRITE_HK(0);
    __syncthreads();
}
__device__ __forceinline__ void attn_block(const unsigned char* wsb, const BlockRef& cur, const BlockRef& nxt, int skv, LAS char* lds, Seam& S, int wave_) {
    const int wid = wave_, lane = fresh_lane(), tid = wid * 64 + lane, r32 = lane & 31, hi = lane >> 5;
    int j_hi = (cur.P0 + QB - 1) / KVBLK + 1; if (j_hi > skv / KVBLK) j_hi = skv / KVBLK;
    const int NT = j_hi;
    const int qlo = cur.P0 + wid * QBLK, qm = qlo + r32 - 4 * hi;
    LAS char* V_lds = lds; LAS char* K_lds = lds + 2 * SHM_V;
    LAS float* wsp = (LAS float*)(lds + 2 * SHM_V + 2 * SHM_K) + wid * 64; LAS float* li_l = wsp; LAS float* al_l = wsp + 32;
    float m_reg = -1e30f, l_reg = 0; f32x16 o[4] = {};
    const int sr = tid >> 4, sc = (tid & 15) * 8, vst0 = v_st(sr, sc), kws = KSWZ(sr, sc * 2);
    const unsigned lo0 = (unsigned)(sr * LDKV + sc), qlo_off = (unsigned)((wid * QBLK + r32) * LDQ + hi * 8);
    const int vb0 = (int)(unsigned)(uintptr_t)V_lds + v_rd_base(lane);
    const bf16_t* Kh = (const bf16_t*)(wsb + cur.k); const bf16_t* Vh = (const bf16_t*)(wsb + cur.v);
    const unsigned long long* Mb = (const unsigned long long*)(wsb + cur.m); const bool masked = cur.m != 0u; const unsigned moff = (unsigned)((wid * QBLK + r32) * NWM);
    unsigned long long mw = ~0ull;
#define MLOAD(t) do { mw = Mb[moff + (unsigned)(t)]; } while (0)
#define RESC(a) do { if (__any((a) < 1.f)) { if (hi == 0) al_l[r32] = (a); asm volatile("s_waitcnt lgkmcnt(0)" ::: "memory");              \
                     for (int d_ = 0; d_ < 4; ++d_) for (int r = 0; r < 16; ++r) o[d_][r] *= al_l[crow(r, hi)]; } } while (0)
#define KBASE(t) ((t) * KVBLK)
#define MASKT(P0_, P1_, t) do { mask_bits(P0_, P1_, mw, hi); } while (0)
    f32x16 pA0, pA1, pB0, pB1; float mnA, mnB, alA, alB; bf16x8 pa0, pa1, pa2, pa3;
    SWRITE_HV(0); SBAR();
    MLOAD(0);
    if (NT > 1) SLOAD_H(Kh, Vh, KBASE(1));
    SBAR(); qkt<0>(pA0, pA1, K_lds, r32, hi, S.qr);
    MASKT(pA0, pA1, 0); partialSM(pA0, pA1, m_reg, mnA, alA);
    if (NT > 1) { VMW(); SWRITE_H(1); }
    __syncthreads();
#define HALF_STEP(PX0, PX1, mnX, alX, PY0, PY1, alY, t, KB, VB, SB) do {                                                      \
        SBAR(); MLOAD(t); qkt<KB>(PX0, PX1, K_lds, r32, hi, S.qr);                                             \
        finishSM(PY0, PY1, alY, l_reg, pa0, pa1, pa2, pa3); SBAR();                                                           \
        if ((t) + 1 < NT) { SLOAD_H(Kh, Vh, KBASE((t) + 1)); SBAR(); }                                               \
        pv_tile<VB>(o, vb0, pa0, pa1, pa2, pa3); MASKT(PX0, PX1, (t)); partialSM(PX0, PX1, m_reg, mnX, alX);                                        \
        __syncthreads();                                                                                                      \
        if ((t) + 1 < NT) { VMW(); SWRITE_H(SB); }                                                                          \
        RESC(alX); __syncthreads(); } while (0)
    for (int t = 1; t + 1 < NT; t += 2) {
        HALF_STEP(pB0, pB1, mnB, alB, pA0, pA1, alA, t, 1, 0, 0);
        HALF_STEP(pA0, pA1, mnA, alA, pB0, pB1, alB, t + 1, 0, 1, 1);
    }
    const bool even = (NT & 1) == 0;
    if (even) { SBAR(); MLOAD(NT - 1); qkt<1>(pB0, pB1, K_lds, r32, hi, S.qr); SBAR(); }
    SLOAD_H((const bf16_t*)(wsb + nxt.k), (const bf16_t*)(wsb + nxt.v), 0); SBAR();
    QLOAD(nxt);
    SBAR();
    finishSM(pA0, pA1, alA, l_reg, pa0, pa1, pa2, pa3); SBAR();
    pv_tile<0>(o, vb0, pa0, pa1, pa2, pa3);
    if (even) { MASKT(pB0, pB1, NT - 1); partialSM(pB0, pB1, m_reg, mnB, alB); __syncthreads(); RESC(alB);
        finishSM(pB0, pB1, alB, l_reg, pa0, pa1, pa2, pa3); SBAR(); pv_tile<1>(o, vb0, pa0, pa1, pa2, pa3); }
    SBAR(); VMWN(8); SWRITE_HK(0); SBAR();
    if (hi == 0) li_l[r32] = l_reg; asm volatile("s_waitcnt lgkmcnt(0)" ::: "memory");
    float rli[16];
#pragma unroll
    for (int r = 0; r < 16; ++r) rli[r] = __builtin_amdgcn_rcpf(li_l[crow(r, hi)]);
    int hiE = hi, r32E = r32; asm volatile("" : "+v"(hiE), "+v"(r32E));
    unsigned char* Ow = (unsigned char*)(wsb + cur.o) + (unsigned)((wid * QBLK + 4 * hiE) * 2048 + r32E);
#pragma unroll
    for (int r = 0; r < 16; ++r) { const int orow = (r & 3) + 8 * (r >> 2);
#pragma unroll
        for (int d0 = 0; d0 < 4; ++d0) { const float v = o[d0][r] * (rli[r] * 16.0f);
            const float vn = xor1f(v);
            const int w = __builtin_amdgcn_cvt_pk_fp8_f32(v, vn, 0, false);
            const int w2 = __builtin_amdgcn_update_dpp(0, w, 0x4E, 0xF, 0xF, true);
            if ((r32 & 3) == 0) *(unsigned*)(Ow + orow * 2048 + d0 * 32) = ((unsigned)w & 0xffffu) | ((unsigned)w2 << 16); } }
    __syncthreads();
#undef MLOAD
#undef RESC
#undef KBASE
#undef MASKT
#undef HALF_STEP
}
#undef VMW
#undef VMWN
#undef SLOAD_H
#undef SWRITE_HK
#undef SWRITE_HV
#undef SWRITE_H
#undef QLOAD

struct CvCtx { const float* w1; const float* w2; const float* wua; const float* wub; const float* wo; unsigned char* ws; int stride; };
constexpr int CV_I1 = (D / 64) * (4096 / 32), CV_I2 = (DFF / 64) * (D / 32), CV_EXP = NE * (CV_I1 + CV_I2);
constexpr int CV_IU = (1024 / 64) * (D / 32), CV_IO = (D / 64) * (D / 32), CV_TOTAL = CV_EXP + 2 * CV_IU + CV_IO;
__device__ __forceinline__ void cv_decode(const CvCtx& c, int r, const float*& src, int& N, unsigned char*& dst) {
    if (r < NE * CV_I1) { const int e = r / CV_I1, w = r % CV_I1, kb = w >> 7, nb = w & 127;
        src = c.w1 + (size_t)e * D * 4096 + (size_t)(64 * kb) * 4096 + 32 * nb; N = 4096; dst = c.ws + WS_W1 + (size_t)e * 4096 * D + (size_t)(32 * nb) * D + 64 * kb; }
    else if (r < CV_EXP) { const int q = r - NE * CV_I1, e = q / CV_I2, w = q % CV_I2, kb = w >> 6, nb = w & 63;
        src = c.w2 + (size_t)e * DFF * D + (size_t)(64 * kb) * D + 32 * nb; N = D; dst = c.ws + WS_W2 + (size_t)e * D * DFF + (size_t)(32 * nb) * DFF + 64 * kb; }
    else { int q = r - CV_EXP; N = D;
        if (q < 2 * CV_IU) { const int second = q >= CV_IU; if (second) q -= CV_IU; const int kb = q >> 6, nb = q & 63;
            src = (second ? c.wub : c.wua) + (size_t)(64 * kb) * D + 32 * nb; dst = c.ws + WS_WUPA + (size_t)(32 * nb) * 2048 + 1024 * second + 64 * kb; }
        else { q -= 2 * CV_IU; const int kb = q >> 6, nb = q & 63; src = c.wo + (size_t)(64 * kb) * D + 32 * nb; dst = c.ws + WS_WOUT + (size_t)(32 * nb) * 2048 + 64 * kb; } }
}
__device__ __forceinline__ unsigned char* cv_load(const CvCtx& c, int r, int lane, f32x4 (&t)[8]) {
    const float* src; int N; unsigned char* dst; cv_decode(c, r, src, N, dst);
    const float* wp = src + (size_t)(lane >> 3) * N + 4 * (lane & 7);
#pragma unroll
    for (int i = 0; i < 8; ++i) t[i] = __builtin_nontemporal_load((const f32x4*)(wp + (size_t)(8 * i) * N));
    return dst;
}
__device__ __forceinline__ void cv_emit(unsigned char* dst, int lane, const f32x4 (&t)[8], LAS unsigned* scr) {
    { const int lr = lane >> 3, c4 = lane & 7;
#pragma unroll
      for (int i = 0; i < 8; ++i) { const f32x4 v = t[i] * F8_WSCALE; scr[(8 * i + lr) * 9 + c4] = cvt4_fp8(v[0], v[1], v[2], v[3]); } }
    LDS_WAIT(); asm volatile("" ::: "memory");
    const int cc = lane & 7, nq = lane >> 5, sh = (lane >> 3) & 3;
    const unsigned selA = (unsigned)sh | ((4u + (unsigned)sh) << 8);
#pragma unroll
    for (int j = 0; j < 4; ++j) { const LAS unsigned* p = scr + (8 * cc) * 9 + nq + 2 * j;
        const unsigned d0 = p[0], d1 = p[9], d2 = p[18], d3 = p[27], d4 = p[36], d5 = p[45], d6 = p[54], d7 = p[63];
        const unsigned p01 = __builtin_amdgcn_perm(d1, d0, selA), p23 = __builtin_amdgcn_perm(d3, d2, selA), p45 = __builtin_amdgcn_perm(d5, d4, selA), p67 = __builtin_amdgcn_perm(d7, d6, selA);
        u32x2 o; o.x = __builtin_amdgcn_perm(p23, p01, 0x05040100u); o.y = __builtin_amdgcn_perm(p67, p45, 0x05040100u);
        const int n = (lane >> 3) + 8 * j;
        __builtin_nontemporal_store(o, (u32x2*)(dst + (size_t)n * 2048 + 8 * cc)); }
    LDS_WAIT(); asm volatile("" ::: "memory");
}
__device__ __forceinline__ void cv_stash(const f32x4 (&t)[8], int lane, LAS unsigned* scr) {
    const int lr = lane >> 3, c4 = lane & 7;
#pragma unroll
    for (int i = 0; i < 8; ++i) { const f32x4 v = t[i] * F8_WSCALE; scr[(8 * i + lr) * 9 + c4] = cvt4_fp8(v[0], v[1], v[2], v[3]); }
}
__device__ __forceinline__ void cv_gather(const LAS unsigned* scr, int lane, int j, unsigned (&g)[8]) {
    const LAS unsigned* p = scr + (8 * (lane & 7)) * 9 + (lane >> 5) + 2 * j;
#pragma unroll
    for (int e = 0; e < 8; ++e) g[e] = p[9 * e];
}
__device__ __forceinline__ void cv_finish(unsigned char* dst, int lane, int j, const unsigned (&g)[8]) {
    const int cc = lane & 7, sh = (lane >> 3) & 3, n = (lane >> 3) + 8 * j; const unsigned selA = (unsigned)sh | ((4u + (unsigned)sh) << 8);
    const unsigned p01 = __builtin_amdgcn_perm(g[1], g[0], selA), p23 = __builtin_amdgcn_perm(g[3], g[2], selA), p45 = __builtin_amdgcn_perm(g[5], g[4], selA), p67 = __builtin_amdgcn_perm(g[7], g[6], selA);
    u32x2 o; o.x = __builtin_amdgcn_perm(p23, p01, 0x05040100u); o.y = __builtin_amdgcn_perm(p67, p45, 0x05040100u);
    __builtin_nontemporal_store(o, (u32x2*)(dst + (size_t)n * 2048 + 8 * cc));
}
template <int VB, int G>
__device__ __forceinline__ void pv_group(f32x16* o, int vb0, bf16x8 pa0, bf16x8 pa1, bf16x8 pa2, bf16x8 pa3) {
#define TRRD(dst, off) asm volatile("ds_read_b64_tr_b16 %0, %1 offset:%2" : "=&v"(dst) : "v"(vb0), "i"(off) : "memory")
    s16x4 l0, l1, l2, l3, h0, h1, h2, h3; constexpr int b_ = VB * SHM_V + v_rd_off(G, 0, 0);
    TRRD(l0, b_); TRRD(h0, b_ + 2048); TRRD(l1, b_ + 4096); TRRD(h1, b_ + 6144); TRRD(l2, b_ + 8192); TRRD(h2, b_ + 10240); TRRD(l3, b_ + 12288); TRRD(h3, b_ + 14336);
    asm volatile("s_waitcnt lgkmcnt(0)" ::: "memory"); SBAR();
    o[G] = __builtin_amdgcn_mfma_f32_32x32x16_bf16(pa0, (bf16x8){l0[0], l0[1], l0[2], l0[3], h0[0], h0[1], h0[2], h0[3]}, o[G], 0, 0, 0);
    o[G] = __builtin_amdgcn_mfma_f32_32x32x16_bf16(pa1, (bf16x8){l1[0], l1[1], l1[2], l1[3], h1[0], h1[1], h1[2], h1[3]}, o[G], 0, 0, 0);
    o[G] = __builtin_amdgcn_mfma_f32_32x32x16_bf16(pa2, (bf16x8){l2[0], l2[1], l2[2], l2[3], h2[0], h2[1], h2[2], h2[3]}, o[G], 0, 0, 0);
    o[G] = __builtin_amdgcn_mfma_f32_32x32x16_bf16(pa3, (bf16x8){l3[0], l3[1], l3[2], l3[3], h3[0], h3[1], h3[2], h3[3]}, o[G], 0, 0, 0);
    SBAR();
#undef TRRD
}
constexpr int CV_SCR0 = 139264, CV_SCRB = 2304;

struct PairRef { unsigned q, k, v, o; int P0; };
constexpr int PB_VLO = 0, PB_VHI = 32768, PB_K = 65536, PB_P = 98304, PB_SM = 135168;
__device__ __forceinline__ void attn_pair_block(const unsigned char* wsb, const PairRef& cur, int skv, LAS char* lds, int wave_, const CvCtx& cv, int& cvr) {
    const int wid = wave_, lane = fresh_lane(), r32 = lane & 31, hi = lane >> 5;
    const bool lead = wid < 4; const int w = wid & 3, tl = w * 64 + lane;
    int j_hi = (cur.P0 + 127) / KVBLK + 1; if (j_hi > skv / KVBLK) j_hi = skv / KVBLK;
    const int NT = j_hi;
    const int qlo = cur.P0 + w * QBLK, qm = qlo + r32 - 4 * hi;
    LAS char* Vlo = lds + PB_VLO; LAS char* Vhi = lds + PB_VHI; LAS char* K_lds = lds + PB_K;
    LAS char* Pb = lds + PB_P + w * 4096 + lane * 64;
    LAS float* li_l = (LAS float*)(lds + PB_SM + w * 1024); LAS float* al_l = li_l + 32; LAS int* afl = (LAS int*)(li_l + 160);
    const int sr = tl >> 4, sc = (tl & 15) * 8;
    const unsigned lo0 = (unsigned)(sr * LDKV + sc);
    const int vst0 = v_st(sr, sc), kws0 = KSWZ(sr, sc * 2);
    const int vb_lo = (int)(unsigned)(uintptr_t)Vlo + v_rd_base(lane), vb_hi = (int)(unsigned)(uintptr_t)Vhi + v_rd_base(lane);
    const bf16_t* Kh = (const bf16_t*)(wsb + cur.k); const bf16_t* Vh = (const bf16_t*)(wsb + cur.v);
#define LD4(dst, base) do { const bf16_t* b_ = (base); dst[0] = load8(b_ + lo0); dst[1] = load8(b_ + 16 * LDKV + lo0); dst[2] = load8(b_ + 32 * LDKV + lo0); dst[3] = load8(b_ + 48 * LDKV + lo0); } while (0)
#define ST4(ptr, src) do { _Pragma("unroll") for (int i_ = 0; i_ < 4; ++i_) *(LAS bf16x8*)((ptr) + 4096 * i_) = src[i_]; } while (0)
#define VMW() asm volatile("s_waitcnt vmcnt(0)" ::: "memory")
#define LGW() asm volatile("s_waitcnt lgkmcnt(0)" ::: "memory")
#define EPILOGUE(colofs) do { float rli[16];                                                                                                         \
        _Pragma("unroll") for (int r = 0; r < 16; ++r) rli[r] = __builtin_amdgcn_rcpf(li_l[crow(r, hi)]);                                            \
        int hiE = hi, r32E = r32; asm volatile("" : "+v"(hiE), "+v"(r32E));                                                                          \
        bf16_t* Ow = (bf16_t*)(wsb + cur.o) + (unsigned)((w * QBLK + 4 * hiE) * LDO + r32E) + (colofs);                                              \
        _Pragma("unroll") for (int r = 0; r < 16; ++r) { const int orow = (r & 3) + 8 * (r >> 2);                                                    \
            _Pragma("unroll") for (int d0 = 0; d0 < 4; ++d0) { const float v = o[d0][r] * rli[r]; const float vn = xor1f(v);                         \
                if ((r32 & 1) == 0) *(unsigned*)(Ow + orow * LDO + d0 * 32) = cvt_pk_bf16(v, vn); } } } while (0)
    if (lead) {
        f32x16 o[4] = {}; float m_reg = -1e30f, l_reg = 0.f;
        bf16x8 qr[8], stA[4]; f32x16 pA0, pA1, pB0, pB1; float mnA, mnB, alA, alB; bf16x8 pa0, pa1, pa2, pa3;
        { const bf16_t* qb_ = (const bf16_t*)(wsb + cur.q) + (unsigned)((w * QBLK + r32) * LDQ + hi * 8);
#pragma unroll
          for (int d0 = 0; d0 < 8; ++d0) qr[d0] = load8(qb_ + d0 * 16); }
        LD4(stA, Vh); VMW(); ST4(Vlo + vst0, stA);
        LGW(); __syncthreads();
        qkt<0>(pA0, pA1, K_lds, r32, hi, qr);
        if (KVBLK - 1 > qlo) { asm volatile("" ::: "memory"); mask_tile(pA0, pA1, qm); }
        partialSM(pA0, pA1, m_reg, mnA, alA);
        if (lane == 0) afl[0] = 0;
        LGW(); __syncthreads();
#define LFULL(s_, PAR, PX0, PX1, mnX, alX, PY0, PY1, alY) do { const int s = (s_);                                                                    \
            SBAR(); qkt<(PAR) ^ 1>(PX0, PX1, K_lds, r32, hi, qr);                                                                                    \
            finishSM(PY0, PY1, alY, l_reg, pa0, pa1, pa2, pa3); SBAR();                                                                              \
            { LAS char* pw_ = Pb + (PAR) * 16384; *(LAS bf16x8*)(pw_) = pa0; *(LAS bf16x8*)(pw_ + 16) = pa1; *(LAS bf16x8*)(pw_ + 32) = pa2; *(LAS bf16x8*)(pw_ + 48) = pa3; } \
            LD4(stA, Vh + (size_t)((s + 1) * KVBLK) * LDKV); SBAR();                                                                                 \
            pv_tile<PAR>(o, vb_lo, pa0, pa1, pa2, pa3);                                                                                              \
            { const int kb_ = (s + 1) * KVBLK; if (kb_ + KVBLK - 1 > qlo) { asm volatile("" ::: "memory"); mask_tile(PX0, PX1, qm - kb_); } }                                           \
            partialSM(PX0, PX1, m_reg, mnX, alX);                                                                                                    \
            VMW(); ST4(Vlo + ((PAR) ^ 1) * SHM_V + vst0, stA);                                                                                       \
            { const bool rs_ = __any((alX) < 1.f); const int sl_ = (s + 1) & 3; if (lane == 0) afl[sl_] = rs_ ? 1 : 0;                               \
              if (rs_) { if (hi == 0) al_l[sl_ * 32 + r32] = (alX); LGW();                                                                           \
                  _Pragma("unroll") for (int d_ = 0; d_ < 4; ++d_) _Pragma("unroll") for (int r = 0; r < 16; ++r) o[d_][r] *= al_l[sl_ * 32 + crow(r, hi)]; } } \
            LGW(); __syncthreads(); } while (0)
#define LLAST(PAR, PY0, PY1, alY) do {                                                                                                               \
            finishSM(PY0, PY1, alY, l_reg, pa0, pa1, pa2, pa3); SBAR();                                                                              \
            { LAS char* pw_ = Pb + (PAR) * 16384; *(LAS bf16x8*)(pw_) = pa0; *(LAS bf16x8*)(pw_ + 16) = pa1; *(LAS bf16x8*)(pw_ + 32) = pa2; *(LAS bf16x8*)(pw_ + 48) = pa3; } \
            pv_tile<PAR>(o, vb_lo, pa0, pa1, pa2, pa3);                                                                                              \
            LGW(); __syncthreads(); } while (0)
        int s2 = 0;
#pragma unroll 1
        for (; s2 + 2 <= NT - 1; s2 += 2) {
            LFULL(s2, 0, pB0, pB1, mnB, alB, pA0, pA1, alA);
            LFULL(s2 + 1, 1, pA0, pA1, mnA, alA, pB0, pB1, alB);
        }
        if (s2 < NT - 1) { LFULL(s2, 0, pB0, pB1, mnB, alB, pA0, pA1, alA); LLAST(1, pB0, pB1, alB); }
        else { LLAST(0, pA0, pA1, alA); }
#undef LFULL
#undef LLAST
        if (hi == 0) li_l[r32] = l_reg;
        LGW(); __syncthreads();
        EPILOGUE(0);
        __syncthreads();
    } else {
        f32x16 o[4] = {}; bf16x8 stA[4], stB[4]; bf16x8 pa0, pa1, pa2, pa3;
        f32x4 cvtA[8], cvtB[8]; unsigned char* cvpA = nullptr; unsigned char* cvpB = nullptr;
        LAS unsigned* cvscr = (LAS unsigned*)(lds + CV_SCR0 + w * CV_SCRB);
        LD4(stA, Kh); VMW(); ST4(K_lds + kws0, stA);
        LGW(); __syncthreads();
        LD4(stA, Kh + (size_t)KVBLK * LDKV); VMW(); ST4(K_lds + SHM_K + kws0, stA);
        LGW(); __syncthreads();
#define FSTEP(s_, PAR, CT, CP) do { const int s = (s_);                                            \
            unsigned char* const dst_ = (CP); const bool em_ = dst_ != nullptr && s >= 1; unsigned g_[8];                                             \
            if (dst_ != nullptr && !em_) cv_emit(dst_, lane, CT, cvscr);                                               \
            if (em_) cv_stash(CT, lane, cvscr);                                                         \
            (CP) = nullptr;                                                                                                                          \
            if (s < NT) LD4(stB, Vh + 128 + (size_t)(s * KVBLK) * LDKV);                                                                             \
            if (s + 2 < NT) LD4(stA, Kh + (size_t)((s + 2) * KVBLK) * LDKV);                                                                         \
            if (cvr < CV_TOTAL && (s & 3) != 3) { (CP) = cv_load(cv, cvr, lane, CT); cvr += cv.stride; }     \
            if (s >= 1) { const LAS char* pr_ = Pb + ((PAR) ^ 1) * 16384;                                                                            \
                pa0 = *(const LAS bf16x8*)(pr_); pa1 = *(const LAS bf16x8*)(pr_ + 16); pa2 = *(const LAS bf16x8*)(pr_ + 32); pa3 = *(const LAS bf16x8*)(pr_ + 48); \
                const int sl_ = (s - 1) & 3;                                                                                                         \
                if (afl[sl_]) { _Pragma("unroll") for (int d_ = 0; d_ < 4; ++d_) _Pragma("unroll") for (int r = 0; r < 16; ++r) o[d_][r] *= al_l[sl_ * 32 + crow(r, hi)]; } \
                pv_group<(PAR) ^ 1, 0>(o, vb_hi, pa0, pa1, pa2, pa3);                                                                                \
                if (em_) cv_gather(cvscr, lane, 0, g_);                                                 \
                pv_group<(PAR) ^ 1, 1>(o, vb_hi, pa0, pa1, pa2, pa3);                                                                                \
                if (em_) { cv_finish(dst_, lane, 0, g_); cv_gather(cvscr, lane, 1, g_); }                                                            \
                pv_group<(PAR) ^ 1, 2>(o, vb_hi, pa0, pa1, pa2, pa3);                                                                                \
                if (em_) { cv_finish(dst_, lane, 1, g_); cv_gather(cvscr, lane, 2, g_); }                                                            \
                pv_group<(PAR) ^ 1, 3>(o, vb_hi, pa0, pa1, pa2, pa3);                                                                                \
                if (em_) { cv_finish(dst_, lane, 2, g_); cv_gather(cvscr, lane, 3, g_); } }                                                          \
            if (s < NT) ST4(Vhi + (PAR) * SHM_V + vst0, stB);                                                                                        \
            if (s + 2 < NT) ST4(K_lds + (PAR) * SHM_K + kws0, stA);                                                                                  \
            LGW(); if (em_) cv_finish(dst_, lane, 3, g_);                                                                                            \
            __syncthreads(); } while (0)
#pragma unroll 1
        for (int s2 = 0; s2 <= NT; s2 += 2) {
            FSTEP(s2, 0, cvtA, cvpA);
            if (s2 + 1 <= NT) FSTEP(s2 + 1, 1, cvtB, cvpB);
        }
#undef FSTEP
        if (cvpA) cv_emit(cvpA, lane, cvtA, cvscr);
        if (cvpB) cv_emit(cvpB, lane, cvtB, cvscr);
        EPILOGUE(128);
        __syncthreads();
    }
#undef EPILOGUE
#undef LD4
#undef ST4
#undef VMW
#undef LGW
}
}

__device__ __forceinline__ at::BlockRef attn_ref(int bv, int qb) {
    const int b = bv / 24, vh = bv - b * 24; const unsigned row = (unsigned)(b * SEQ + qb * 256);
    at::BlockRef r; r.P0 = NMETA + qb * 256;
    if (vh < 8) { const unsigned h = (unsigned)vh;
        r.q = (unsigned)WS_QA + (row * 1024u + h * 128u) * 2u; r.k = (unsigned)WS_KA + ((unsigned)(b * TP) * 1024u + h * 128u) * 2u; r.v = (unsigned)WS_VA + ((unsigned)(b * TP) * 1024u + h * 128u) * 2u;
        r.o = (unsigned)WS_OA8 + row * 2048u + h * 128u; r.m = (unsigned)WS_MASK + row * (unsigned)at::NWM * 8u; }
    else { const unsigned j = (unsigned)(vh - 8), h = j >> 2, br = (j >> 1) & 1u, hf = j & 1u;
        r.q = (unsigned)WS_QB + (row * 1024u + h * 256u + br * 128u) * 2u; r.k = (unsigned)WS_KB + ((unsigned)(b * TP) * 1024u + h * 256u + br * 128u) * 2u; r.v = (unsigned)WS_VB + ((unsigned)(b * TP) * 1024u + h * 256u + hf * 128u) * 2u;
        r.o = (unsigned)WS_OALL + (row * (unsigned)at::LDO + 1024u + h * 512u + br * 256u + hf * 128u) * 2u; r.m = 0u; }
    return r;
}
__device__ __forceinline__ void attn_item(int L, int& bv, int& qb0, int& qb1) { const int xcd = L & 7, slot = (L >> 3) & 31, rnd = L >> 8; bv = rnd * 16 + xcd * 2 + (slot >> 4); const int pair = slot & 15; qb0 = pair; qb1 = 31 - pair; }
__device__ __forceinline__ void attn_phase(Frame& F) {
    constexpr int TOTAL = 768; const int stride = F.G;
    LAS char* lds = (LAS char*)(F.lds + RING_OFF);
    const unsigned char* wsb = F.ws;
    const at::CvCtx cv{F.in[15], F.in[17], F.in[9], F.in[10], F.in[11], F.ws, 4 * F.G};
    int cvr = (int)blockIdx.x * 4 + (F.wave & 3);
    for (int L = (int)blockIdx.x; L < TOTAL; L += stride) {
        const int xcd = L & 7, slot = (L >> 3) & 31, rnd = L >> 8; const int bv = rnd * 16 + xcd * 2 + (slot >> 4), pr = slot & 15;
        const int b = bv / 24, vh = bv - b * 24;
        if (vh < 8) {
            at::BlockRef cur = attn_ref(bv, pr); const at::BlockRef nxt = attn_ref(bv, 31 - pr);
            at::Seam S;
            at::attn_prime(wsb, cur, lds, S, F.wave);
            at::attn_block(wsb, cur, nxt, TP, lds, S, F.wave);
            at::attn_block(wsb, nxt, nxt, TP, lds, S, F.wave);
            __syncthreads();
        } else {
            const unsigned j = (unsigned)(vh - 8), h = j >> 2, br = (j >> 1) & 1u, hf = j & 1u; const int p = 16 * (int)hf + pr;
#pragma unroll 1
            for (int pass = 0; pass < 2; ++pass) {
                const int qb = pass ? 63 - p : p; const unsigned row = (unsigned)(b * SEQ + qb * 128);
                at::PairRef r; r.P0 = NMETA + qb * 128;
                r.q = (unsigned)WS_QB + (row * 1024u + h * 256u + br * 128u) * 2u; r.k = (unsigned)WS_KB + ((unsigned)(b * TP) * 1024u + h * 256u + br * 128u) * 2u;
                r.v = (unsigned)WS_VB + ((unsigned)(b * TP) * 1024u + h * 256u) * 2u; r.o = (unsigned)WS_OALL + (row * (unsigned)at::LDO + 1024u + h * 512u + br * 256u) * 2u;
                at::attn_pair_block(wsb, r, TP, lds, F.wave, cv, cvr);
            }
        }
    }
    {
        LAS int* cvsh = (LAS int*)(lds + at::CV_SCR0); const int lane = fresh_lane();
        __syncthreads();
        if (F.wave >= 4 && lane == 0) cvsh[F.wave - 4] = cvr;
        __syncthreads();
        int r = cvsh[F.wave & 3] + (F.wave >> 2) * cv.stride;
        __syncthreads();
        LAS unsigned* scr = (LAS unsigned*)(F.lds + RING_OFF + F.wave * 16384);
        for (; r < at::CV_TOTAL; r += 2 * cv.stride) { f32x4 t[8]; unsigned char* d = at::cv_load(cv, r, lane, t); at::cv_emit(d, lane, t, scr); }
    }
}
__device__ __forceinline__ void diff_phase(Frame& F) {
    const int gw = F.vcu * NWAVES + F.wave, NGW = F.G * NWAVES, lane = fresh_lane();
    const float* lq1 = F.in[4]; const float* lk1 = F.in[5]; const float* lq2 = F.in[6]; const float* lk2 = F.in[7]; const float* sg = F.in[8];
    const float s1 = wave_sum(lq1[lane] * lk1[lane] + lq1[lane + 64] * lk1[lane + 64]), s2 = wave_sum(lq2[lane] * lk2[lane] + lq2[lane + 64] * lk2[lane + 64]);
    const float lam = __expf(s1) - __expf(s2) + 0.2f;
    const f32x4 g4 = *(const f32x4*)(sg + 4 * lane);
    const bf16_t* OBR = (const bf16_t*)(F.ws + WS_OALL) + 1024; unsigned char* OB8 = F.ws + WS_OA8 + 1024;
    for (int r = gw; r < NX; r += NGW) {
#pragma unroll
        for (int h = 0; h < 4; ++h) {
            const u32x2 a = *(const u32x2*)(OBR + (size_t)r * at::LDO + h * 512 + 4 * lane), c = *(const u32x2*)(OBR + (size_t)r * at::LDO + h * 512 + 256 + 4 * lane);
            f32x4 d;
            d[0] = __uint_as_float(a.x << 16) - lam * __uint_as_float(c.x << 16); d[1] = __uint_as_float(a.x & 0xffff0000u) - lam * __uint_as_float(c.x & 0xffff0000u);
            d[2] = __uint_as_float(a.y << 16) - lam * __uint_as_float(c.y << 16); d[3] = __uint_as_float(a.y & 0xffff0000u) - lam * __uint_as_float(c.y & 0xffff0000u);
            const float ss = wave_sum((d[0] * d[0] + d[1] * d[1]) + (d[2] * d[2] + d[3] * d[3]));
            const float rs = 0.8f / sqrtf(ss * (1.0f / 256.0f) + EPS);
            *(unsigned*)(OB8 + (size_t)r * D + h * 256 + 4 * lane) = cvt4_fp8(d[0] * rs * g4[0], d[1] * rs * g4[1], d[2] * rs * g4[2], d[3] * rs * g4[3]);
        }
    }
}
typedef float f32x16i __attribute__((ext_vector_type(16)));
constexpr int IDX_ROWB = 144, IDX_CHUNK = 128, IDX_BUF = IDX_CHUNK * IDX_ROWB;
__device__ __forceinline__ void idx_phase(Frame& F) {
    const int lane = fresh_lane(), wave = F.wave, tid = wave * 64 + lane, n = lane & 31, hh = lane >> 5;
    const bf16_t* QI = (const bf16_t*)(F.ws + WS_QI); const bf16_t* KI = (const bf16_t*)(F.ws + WS_KI); const float* WI = (const float*)(F.ws + WS_WI); float* SC = (float*)(F.ws + WS_SC);
    LAS unsigned char* buf = F.lds + RING_OFF;
    for (int L = (int)blockIdx.x; L < 512; L += F.G) {
        const int b = (L >> 7) & 1, j = L & 127, hu = (L >> 8) ? 255 - j : j;
        const int P = NMETA + hu * 32;
        const int r0 = b * SEQ + hu * 32 + wave * 4;
        const int qq = (lane >> 2) & 1, hA = (lane & 3) + 4 * (n >> 3);
        bf16x8 afr[2][4]; float wv[2][16];
#pragma unroll
        for (int p = 0; p < 2; ++p) {
            const bf16_t* qp = QI + (size_t)(r0 + 2 * p + qq) * 1024 + hA * 64 + 8 * hh;
#pragma unroll
            for (int s = 0; s < 4; ++s) afr[p][s] = *(const bf16x8*)(qp + 16 * s);
            const float* wp = WI + (size_t)(r0 + 2 * p + hh) * 16;
#pragma unroll
            for (int h4 = 0; h4 < 4; ++h4) { const f32x4 t = *(const f32x4*)(wp + 4 * h4); wv[p][4 * h4] = t[0]; wv[p][4 * h4 + 1] = t[1]; wv[p][4 * h4 + 2] = t[2]; wv[p][4 * h4 + 3] = t[3]; }
        }
        const int lastpos = P + 31, nch = lastpos / IDX_CHUNK + 1;
        const bf16_t* kbase = KI + (size_t)b * TP * 64;
        const int k0i = tid >> 3, c16 = tid & 7;
        u32x4 st0, st1;
        __syncthreads();
        st0 = *(const u32x4*)(kbase + (size_t)(k0i) * 64 + c16 * 8); st1 = *(const u32x4*)(kbase + (size_t)(k0i + 64) * 64 + c16 * 8);
        *(LAS u32x4*)(buf + k0i * IDX_ROWB + c16 * 16) = st0; *(LAS u32x4*)(buf + (k0i + 64) * IDX_ROWB + c16 * 16) = st1;
        __syncthreads();
        for (int c = 0; c < nch; ++c) {
            const bool more = c + 1 < nch;
            if (more) { const bf16_t* kp = kbase + (size_t)((c + 1) * IDX_CHUNK) * 64;
                st0 = *(const u32x4*)(kp + (size_t)(k0i) * 64 + c16 * 8); st1 = *(const u32x4*)(kp + (size_t)(k0i + 64) * 64 + c16 * 8); }
            LAS unsigned char* cb = buf + (c & 1) * IDX_BUF;
#pragma unroll
            for (int sub = 0; sub < 4; ++sub) {
                const int key0 = c * IDX_CHUNK + sub * 32;
                if (key0 <= lastpos) {
                    bf16x8 bfr[4];
#pragma unroll
                    for (int s = 0; s < 4; ++s) bfr[s] = *(const LAS bf16x8*)(cb + (sub * 32 + n) * IDX_ROWB + (16 * s + 8 * hh) * 2);
#pragma unroll
                    for (int p = 0; p < 2; ++p) {
                        f32x16i acc = {};
#pragma unroll
                        for (int s = 0; s < 4; ++s) acc = __builtin_amdgcn_mfma_f32_32x32x16_bf16(afr[p][s], bfr[s], acc, 0, 0, 0);
                        float sc = 0.f;
#pragma unroll
                        for (int h = 0; h < 16; ++h) sc = fmaf(wv[p][h], fmaxf(acc[h], 0.f), sc);
                        SC[(size_t)(r0 + 2 * p + hh) * TP + key0 + n] = sc;
                    }
                }
            }
            if (more) { LAS unsigned char* nb = buf + ((c + 1) & 1) * IDX_BUF;
                *(LAS u32x4*)(nb + k0i * IDX_ROWB + c16 * 16) = st0; *(LAS u32x4*)(nb + (k0i + 64) * IDX_ROWB + c16 * 16) = st1; }
            __syncthreads();
        }
    }
}
__device__ __forceinline__ unsigned f2key(float f) { const unsigned u = __float_as_uint(f); return (u & 0x80000000u) ? ~u : (u | 0x80000000u); }
__device__ __forceinline__ void topk_phase(Frame& F) {
    const int gw = F.vcu * NWAVES + F.wave, NGW = F.G * NWAVES, lane = fresh_lane();
    const float* SC = (const float*)(F.ws + WS_SC); unsigned long long* MASK = (unsigned long long*)(F.ws + WS_MASK);
    LAS unsigned* cbuf = (LAS unsigned*)(F.lds + RING_OFF + F.wave * 8192);
    for (int row = gw; row < NX; row += NGW) {
        const int q = row & (SEQ - 1), n = NMETA + q + 1;
        const float* sr = SC + (size_t)row * TP;
        unsigned key[128]; unsigned key128;
        const int dln = 128 * lane - n;
        {
            const f32x4* lp = (const f32x4*)(sr + 128 * lane);
            const bool live = dln < 0;
#pragma unroll
            for (int j4 = 0; j4 < 32; ++j4) { f32x4 v = {0.f, 0.f, 0.f, 0.f}; if (live) v = lp[j4];
#pragma unroll
                for (int e = 0; e < 4; ++e) { const int j = 4 * j4 + e; const unsigned u = __float_as_uint(v[e]); const unsigned sgn = (unsigned)((int)u >> 31);
                    key[j] = (u ^ (sgn | 0x80000000u)) & (unsigned)((dln + j) >> 31); }
                if ((j4 & 7) == 7) __builtin_amdgcn_sched_barrier(0); }
            const unsigned u = __float_as_uint(sr[8192 + (lane & 15)]); const unsigned sgn = (unsigned)((int)u >> 31);
            key128 = (lane < 16 && 8192 + lane < n) ? (u ^ (sgn | 0x80000000u)) : 0u;
        }
        unsigned thr = 1u; bool exact = true;
        if (n > 256) {
            exact = false; bool done = false; unsigned prefix = 0u;
            unsigned ts = 1u;
            if (n > 1536) {
                ts = 0u;
                for (int bit = 31; bit >= 14; --bit) {
                    const unsigned cand = ts | (1u << bit); int cl = 0;
#pragma unroll
                    for (int i = 0; i < 8; ++i) cl += __popcll(__ballot(key[16 * i] >= cand));
                    if (cl >= 34) ts = cand;
                }
            }
            LAS unsigned* dump = cbuf + 24 * 64 + lane; int ctot = 0;
#pragma unroll
            for (int j = 0; j < 129; ++j) { const unsigned kv = j < 128 ? key[j] : key128; const bool p = kv >= ts;
                const unsigned long long m = __ballot(p);
                const int pos = ctot + (int)__builtin_amdgcn_mbcnt_hi((unsigned)(m >> 32), __builtin_amdgcn_mbcnt_lo((unsigned)m, 0u));
                LAS unsigned* a = (p && pos < 24 * 64) ? cbuf + pos : dump; *a = kv; ctot += __popcll(m);
                if ((j & 7) == 7) __builtin_amdgcn_sched_barrier(0); }
            LDS_WAIT(); asm volatile("" ::: "memory");
            if (ctot >= 256 && ctot <= 24 * 64) {
                unsigned cd[24]; const int nr = (ctot + 63) >> 6;
#pragma unroll
                for (int r = 0; r < 24; ++r) { const unsigned v = cbuf[64 * r + lane]; cd[r] = (64 * r + lane < ctot) ? v : 0u; }
                for (int bit = 31; bit >= 0; --bit) {
                    const unsigned cand = prefix | (1u << bit); int cnt = 0;
#pragma unroll
                    for (int r = 0; r < 24; ++r) if (r < nr) cnt += __popcll(__ballot(cd[r] >= cand));
                    if (cnt >= 256) { prefix = cand; if (cnt == 256) { exact = true; break; } }
                }
                done = true;
            }
            LDS_WAIT(); asm volatile("" ::: "memory");
            if (!done) {
                prefix = 0u; exact = false;
                for (int bit = 31; bit >= 0; --bit) {
                    const unsigned cand = prefix | (1u << bit); int cl = (key128 >= cand) ? 1 : 0;
#pragma unroll
                    for (int j = 0; j < 128; ++j) cl += (key[j] >= cand) ? 1 : 0;
#pragma unroll
                    for (int o = 1; o < 64; o <<= 1) cl += __shfl_xor(cl, o);
                    const int cnt = __builtin_amdgcn_readfirstlane(cl);
                    if (cnt >= 256) { prefix = cand; if (cnt == 256) { exact = true; break; } }
                }
            }
            thr = prefix;
        }
        unsigned w0 = 0u, w1 = 0u, w2 = 0u, w3 = 0u; unsigned long long wx;
        if (__builtin_expect(exact, 1)) {
#pragma unroll
            for (int j = 31; j >= 0; --j) { w0 = w0 + w0 + ((key[j] >= thr) ? 1u : 0u); w1 = w1 + w1 + ((key[32 + j] >= thr) ? 1u : 0u); w2 = w2 + w2 + ((key[64 + j] >= thr) ? 1u : 0u); w3 = w3 + w3 + ((key[96 + j] >= thr) ? 1u : 0u); }
            wx = __ballot(key128 >= thr);
        } else {
            unsigned thr2 = thr; asm volatile("" : "+v"(thr2));
            int cg = (key128 > thr2) ? 1 : 0, ce = 0;
#pragma unroll
            for (int j = 0; j < 128; ++j) { cg += (key[j] > thr2) ? 1 : 0; ce += (key[j] == thr2) ? 1 : 0; }
            int cgt = cg;
#pragma unroll
            for (int o = 1; o < 64; o <<= 1) cgt += __shfl_xor(cgt, o);
            const int need = 256 - __builtin_amdgcn_readfirstlane(cgt);
            int incl = ce;
#pragma unroll
            for (int o = 1; o < 64; o <<= 1) { const int t = __shfl_up(incl, o); if (lane >= o) incl += t; }
            const int before = incl - ce; const int etot = __shfl(incl, 63);
            int allow = need - before; allow = allow < 0 ? 0 : allow;
            int seen = 0;
#define TK_BIT(W, J) { const unsigned kv_ = key[J]; const bool eq_ = kv_ == thr; const bool tk_ = (kv_ > thr) || (eq_ && seen < allow); seen += eq_ ? 1 : 0; W |= tk_ ? (1u << ((J) & 31)) : 0u; }
#pragma unroll
            for (int j = 0; j < 32; ++j) TK_BIT(w0, j)
#pragma unroll
            for (int j = 32; j < 64; ++j) TK_BIT(w1, j)
#pragma unroll
            for (int j = 64; j < 96; ++j) TK_BIT(w2, j)
#pragma unroll
            for (int j = 96; j < 128; ++j) TK_BIT(w3, j)
#undef TK_BIT
            const bool eqx = key128 == thr; const unsigned long long mx = __ballot(eqx);
            const int rankx = etot + (int)__builtin_amdgcn_mbcnt_hi((unsigned)(mx >> 32), __builtin_amdgcn_mbcnt_lo((unsigned)mx, 0u));
            wx = __ballot((key128 > thr) || (eqx && rankx < need));
        }
        unsigned long long* mr = MASK + (size_t)row * 129;
        *(u32x4*)(mr + 2 * lane) = (u32x4){w0, w1, w2, w3};
        if (lane == 0) mr[128] = wx & 0xffffull;
    }
}

struct Args { const float* in[20]; float* out; unsigned char* ws; int ph_lo, ph_hi, li, pad; };
constexpr int NPHASE = 13;

__global__ void __launch_bounds__(NTHR, 2) mega(Args args) {
    extern __shared__ __attribute__((aligned(16))) unsigned char lds_raw[];
    Frame F;
    F.lds = (LAS unsigned char*)lds_raw;
    F.MISC = (volatile LAS unsigned*)(F.lds + MISC_OFF);
    F.wave = __builtin_amdgcn_readfirstlane(threadIdx.x >> 6);
    F.G = gridDim.x; { const int bx = blockIdx.x; F.vcu = (F.G % 8 == 0) ? (bx % 8) * (F.G / 8) + bx / 8 : bx; }
    F.ws = args.ws; F.ctl = (unsigned*)(args.ws + WS_CTL); F.out = args.out;
#pragma unroll
    for (int i = 0; i < 20; ++i) F.in[i] = args.in[i];
    for (int u = (int)threadIdx.x; u < (LDS_BYTES - LDSCTL_OFF) / 4; u += NTHR) ((LAS unsigned*)(F.lds + LDSCTL_OFF))[u] = 0u;
    __syncthreads();
    XcdBarrier bar = xcd_barrier_post(F.ctl + CW_BAR + args.li * XCD_BAR_WORDS, F.MISC + 8); bar.wave = F.wave;
    const int lo = args.ph_lo, hi = args.ph_hi;
    unsigned char* ws = F.ws;
    volatile LAS int* tb = (volatile LAS int*)(F.lds + MOE_TB_OFF); volatile LAS int* cnt = (volatile LAS int*)(F.lds + MOE_CNT_OFF);
#define IN(k) (lo <= (k) && (k) < hi)
#define SEAM(k) do { if (IN(k) && hi > (k) + 1) xcd_barrier(bar); } while (0)
    if (IN(0)) { p0_prologue(F); SEAM(0); }
    if (IN(1)) {
        {
            WindowOrder S; S.init(MROWS / 256, GATE_TILE0 + 1, 0, F.G, (int)blockIdx.x);
            struct Remap { WindowOrder w; __device__ bool next(int i, Unit& u) const { if (!w.next(i, u)) return false; if (u.pn == GATE_TILE0) u.pn = 44; return true; } __device__ __forceinline__ int rows(const Unit&) const { return 256; } } R{S};
            DenseAB P{(const char*)(ws + WS_HN), (const char*)(ws + WS_WIN), D, D};
            EpiInProj E{ws, 1.0f};
            gemm_phase(F.lds + RING_OFF, 2 * D, R, P, E, F.wave);
        }
        {
            struct GateOrder { DenseOrder d; int c, G, nb8;
                __device__ bool next(int i, Unit& u) const {
                    int L;
                    if (G != 256) { L = i * G + c; if (L >= 1024) return false; }
                    else if (i < 3) L = i * 256 + c;
                    else if (i == 3 && c >= nb8) L = 768 + (c - nb8);
                    else if (i == 4 && c >= nb8 && c < 2 * nb8) L = 768 + (256 - nb8) + (c - nb8);
                    else return false;
                    DenseOrder t = d; t.c = L % G; if (!t.next(L / G, u)) return false; u.pn += GATE_TILE0; return true; }
                __device__ __forceinline__ int rows(const Unit&) const { return 256; } };
            GateOrder S; S.d.init(NX / 256, 16, F.G, 0); S.c = (int)blockIdx.x; S.G = F.G; S.nb8 = ((MROWS / 256) * (GATE_TILE0 + 1)) % 256;
            DenseAB8 P{(const char*)(ws + WS_HN8), (const char*)(ws + WS_WIN8), D, D, GATE_TILE0};
            EpiInProj E{ws, F8_WINV};
            gemm_phase<true>(F.lds + RING_OFF, D, S, P, E, F.wave);
        }
        SEAM(1);
    }
    if (IN(2)) { idx_phase(F); SEAM(2); }
    if (IN(3)) { topk_phase(F); SEAM(3); }
    if (IN(4)) { attn_phase(F); SEAM(4); }
    if (IN(5)) { diff_phase(F); SEAM(5); }
    if (IN(6)) {
        DenseOrder S; S.init(NX / 256, D / 256, F.G, (int)blockIdx.x);
        DenseAB8 P{(const char*)(ws + WS_OA8), (const char*)(ws + WS_WUPA), D, D, 0};
        EpiUp E{(const bf16_t*)(ws + WS_GA), (const bf16_t*)(ws + WS_GB), ws + WS_MG, 1.0f / OA8_SCALE, F8_WINV};
        gemm_phase<true>(F.lds + RING_OFF, D, S, P, E, F.wave);
        SEAM(6);
    }
    if (IN(8)) {
        DenseOrder S; S.init(NX / 256, D / 256, F.G, (int)blockIdx.x);
        DenseAB8 P{(const char*)(ws + WS_MG), (const char*)(ws + WS_WOUT), D, D, 0};
        EpiOut E{F.in[0], (bf16_t*)(ws + WS_H1), F8_WINV};
        gemm_phase<true>(F.lds + RING_OFF, D, S, P, E, F.wave);
        SEAM(8);
    }
    if (IN(9)) { router_phase(F); SEAM(9); }
    if (IN(10)) {
        moe_tables(F);
        MoeOrder S{F.G, (int)blockIdx.x, 4096 / 256, tb};
        MoeAB1 P{(const char*)(ws + WS_HB), (const char*)(ws + WS_W1), (const int*)(ws + WS_LIST), tb, cnt};
        EpiMoe1 E{F.in[16], ws + WS_G};
        gemm_phase<true>(F.lds + RING_OFF, D, S, P, E, F.wave);
        SEAM(10);
    }
    if (IN(11)) {
        moe_tables(F);
        MoeOrder S{F.G, (int)blockIdx.x, D / 256, tb};
        MoeAB2 P{(const char*)(ws + WS_G), (const char*)(ws + WS_W2)};
        EpiMoe2 E{F.in[18], (bf16_t*)(ws + WS_Y)};
        gemm_phase<true>(F.lds + RING_OFF, DFF, S, P, E, F.wave);
        SEAM(11);
    }
    if (IN(12)) { moe_tables(F); final_phase(F); }
#undef IN
#undef SEAM
}

}
#ifndef MK_PER_PHASE
#define MK_PER_PHASE 0
#endif
extern "C" void kernel_launch(void* const* d_in, const int* in_sizes, int n_in, void* d_out, int out_size, void* d_ws, size_t ws_size, hipStream_t stream) {
    static int grid = 0;
    if (grid == 0) {
        if (n_in != 20 || out_size != mk::NX * mk::D || ws_size < mk::WS_END2) { fprintf(stderr, "kernel_launch: unexpected problem shape or workspace (n_in %d, out %d, ws %zu < %zu)\n", n_in, out_size, ws_size, (size_t)mk::WS_END2); grid = -1; return; }
        int dev = 0, cus = 0;
        if (hipGetDevice(&dev) != hipSuccess || hipDeviceGetAttribute(&cus, hipDeviceAttributeMultiprocessorCount, dev) != hipSuccess) { grid = -1; return; }
        if (hipFuncSetAttribute((const void*)mk::mega, hipFuncAttributeMaxDynamicSharedMemorySize, mk::LDS_BYTES) != hipSuccess) { fprintf(stderr, "hipFuncSetAttribute failed\n"); grid = -1; return; }
        int per_cu = 0; (void)hipOccupancyMaxActiveBlocksPerMultiprocessor(&per_cu, (const void*)mk::mega, mk::NTHR, mk::LDS_BYTES); (void)hipGetLastError();
        grid = cus;
    }
    if (grid < 0) return;
    (void)hipMemsetAsync((char*)d_ws + mk::WS_CTL, 0, mk::CTL_BYTES, stream);
    mk::Args a{};
    for (int i = 0; i < 20; ++i) a.in[i] = (const float*)d_in[i];
    a.out = (float*)d_out; a.ws = (unsigned char*)d_ws;
#if MK_PER_PHASE
    for (int ph = 0; ph < mk::NPHASE; ++ph) { a.ph_lo = ph; a.ph_hi = ph + 1; a.li = ph; hipLaunchKernelGGL(mk::mega, dim3(grid), dim3(mk::NTHR), mk::LDS_BYTES, stream, a); }
#else
    a.ph_lo = 0; a.ph_hi = mk::NPHASE; a.li = 0;
    hipLaunchKernelGGL(mk::mega, dim3(grid), dim3(mk::NTHR), mk::LDS_BYTES, stream, a);
#endif
}
```

```cpp
#include <hip/hip_runtime.h>
#include <cstdio>
#include <cstdint>
#include <cmath>

namespace mk {
#define LAS __attribute__((address_space(3)))
#define GAS __attribute__((address_space(1)))
typedef unsigned short bf16_t;
typedef short bf16x8 __attribute__((ext_vector_type(8)));
typedef float f32x4 __attribute__((ext_vector_type(4)));
typedef float f32x2 __attribute__((ext_vector_type(2)));
typedef unsigned u32x4 __attribute__((ext_vector_type(4)));
typedef unsigned u32x2 __attribute__((ext_vector_type(2)));

constexpr int NWAVES = 8, NTHR = 512;
constexpr int D = 2048, SEQ = 8192, NX = 16384, NMETA = 16, T = 8208, TP = 8256;
constexpr int MROWS = 16640;
constexpr int NIN = 11520;
constexpr int DIN = 11344;
constexpr int NE = 32, DFF = 2048;
constexpr float EPS = 1e-5f;
constexpr size_t al256(size_t x) { return (x + 255) & ~(size_t)255; }
constexpr size_t WS_CTL = 0, CTL_BYTES = 1u << 20;
constexpr size_t WS_ROPE = WS_CTL + CTL_BYTES;
constexpr size_t WS_ROPEI = WS_ROPE + al256((size_t)T * 64 * 8);
constexpr size_t WS_WIN = WS_ROPEI + al256((size_t)T * 32 * 8);
constexpr size_t WS_WUPA = WS_WIN + (size_t)NIN * D * 2;
constexpr size_t WS_WUPB = WS_WUPA + (size_t)D * 1024 * 2;
constexpr size_t WS_WOUT = WS_WUPB + (size_t)D * 1024 * 2;
constexpr size_t WS_W1 = WS_WOUT + (size_t)D * D * 2;
constexpr size_t WS_W2 = WS_W1 + (size_t)NE * 4096 * D * 2;
constexpr size_t WS_WR = WS_W2 + (size_t)NE * D * DFF * 2;
constexpr size_t WS_HN = WS_WR + (size_t)2 * NE * D * 2;
constexpr size_t WS_QA = WS_HN + (size_t)MROWS * D * 2;
constexpr size_t WS_KA = WS_QA + (size_t)NX * 1024 * 2;
constexpr size_t WS_VA = WS_KA + (size_t)2 * TP * 1024 * 2;
constexpr size_t WS_QI = WS_VA + (size_t)2 * TP * 1024 * 2;
constexpr size_t WS_KI = WS_QI + (size_t)NX * 1024 * 2;
constexpr size_t WS_WI = WS_KI + (size_t)2 * TP * 64 * 2;
constexpr size_t WS_QB = WS_WI + (size_t)NX * 16 * 4;
constexpr size_t WS_KB = WS_QB + (size_t)NX * 1024 * 2;
constexpr size_t WS_VB = WS_KB + (size_t)2 * TP * 1024 * 2;
constexpr size_t WS_GA = WS_VB + (size_t)2 * TP * 1024 * 2;
constexpr size_t WS_GB = WS_GA + (size_t)NX * D * 2;
constexpr size_t WS_END1 = WS_GB + (size_t)NX * D * 2;
constexpr int GATE_TILE0 = 28, GATE_COL0 = 7248;
constexpr int MAXL = 16384;
constexpr int MAXT = 288;
constexpr size_t WS_OA = WS_END1;
constexpr size_t WS_OB = WS_OA + (size_t)NX * 1024 * 2;
constexpr size_t WS_MGF = WS_OB + (size_t)NX * 1024 * 2;
constexpr size_t WS_MG = WS_MGF + (size_t)NX * D * 4;
constexpr size_t WS_H1 = WS_MG + (size_t)NX * D * 2;
constexpr size_t WS_HB = WS_H1 + (size_t)NX * D * 4;
constexpr size_t WS_GATE = WS_HB + (size_t)NX * D * 2;
constexpr size_t WS_SEI = WS_GATE + (size_t)NX * 4 * 4;
constexpr size_t WS_LIST = WS_SEI + (size_t)NX * 4 * 4;
constexpr size_t WS_G = WS_LIST + (size_t)NE * MAXL * 4;
constexpr size_t WS_Y = WS_G + (size_t)MAXT * 256 * DFF * 2;
constexpr size_t WS_MASK = WS_Y + (size_t)MAXT * 256 * D * 2;
constexpr size_t WS_OALL = WS_MASK + al256((size_t)NX * 129 * 8);
constexpr size_t WS_SC = WS_OALL + (size_t)NX * 3072 * 2;
constexpr size_t WS_END2 = WS_SC + (size_t)NX * TP * 4;

constexpr size_t WS_WIN8 = WS_OA, WS_HN8 = WS_MGF;
constexpr size_t WS_OA8 = WS_SC;
constexpr float OA8_SCALE = 16.0f;
constexpr int CW_BAR = 4096;
constexpr int CW_CNT = 65536;

constexpr int RING_OFF = 0, RING_BYTES = 131072;
constexpr int LDSCTL_OFF = RING_BYTES, MISC_OFF = LDSCTL_OFF + 320;
constexpr int MOE_TB_OFF = LDSCTL_OFF + 1024, MOE_CNT_OFF = LDSCTL_OFF + 1280;
constexpr int LDS_BYTES = 163840;

typedef __bf16 bf16x2_t __attribute__((ext_vector_type(2)));
__device__ __forceinline__ unsigned cvt_pk_bf16(float lo, float hi) { f32x2 v = {lo, hi}; bf16x2_t b = __builtin_convertvector(v, bf16x2_t); return __builtin_bit_cast(unsigned, b); }
typedef int i32x4 __attribute__((ext_vector_type(4)));
typedef int i32x8 __attribute__((ext_vector_type(8)));
constexpr float F8_WSCALE = 64.0f, F8_WINV = 1.0f / 64.0f;
__device__ __forceinline__ unsigned cvt4_fp8(float a, float b, float c, float d) { int w = 0; w = __builtin_amdgcn_cvt_pk_fp8_f32(a, b, w, false); w = __builtin_amdgcn_cvt_pk_fp8_f32(c, d, w, true); return (unsigned)w; }
__device__ __forceinline__ float bf2f(bf16_t b) { return __uint_as_float(((unsigned)b) << 16); }
__device__ __forceinline__ unsigned f2bf(float f) { unsigned u = __float_as_uint(f); return (u + 0x7fffu + ((u >> 16) & 1u)) >> 16; }
__device__ __forceinline__ int fresh_lane() { int l = (int)__builtin_amdgcn_mbcnt_hi(~0u, __builtin_amdgcn_mbcnt_lo(~0u, 0u)); asm volatile("" : "+v"(l)); return l; }
#define LDS_WAIT() asm volatile("s_waitcnt lgkmcnt(0)" ::: "memory")
#define VM_WAIT() asm volatile("s_waitcnt vmcnt(0)" ::: "memory")

#define XB_TMO      128
#define XB_XCNT(j)  (256  + 64 * (j))
#define XB_XSUB(j)  (1280 + 64 * (j))
#define XB_XGEN(j)  (2304 + 64 * (j))
#define XB_TOP      3328
#define XB_TOPGEN   3392
#define XCD_BAR_WORDS 3456
#define XB_SPIN_CAP (1u << 18)
__device__ __forceinline__ unsigned xb_ld(unsigned* p)              { return __hip_atomic_load(p, __ATOMIC_RELAXED, __HIP_MEMORY_SCOPE_AGENT); }
__device__ __forceinline__ unsigned xb_add(unsigned* p, unsigned v) { return __hip_atomic_fetch_add(p, v, __ATOMIC_RELAXED, __HIP_MEMORY_SCOPE_AGENT); }
__device__ __forceinline__ unsigned xb_xcc_id() { return (unsigned)__builtin_amdgcn_s_getreg((3 << 11) | 20) & 0xFu; }
#define XB_SPIN(cond, bar) do { unsigned _sp = 0; while (cond) { __builtin_amdgcn_s_sleep(1); \
    if ((++_sp & 255u) == 0u) { if (xb_ld(&(bar)[XB_TMO])) break; if (_sp > XB_SPIN_CAP) { atomicAdd(&(bar)[XB_TMO], 1u); break; } } } } while (0)
struct XcdBarrier { unsigned* bar; unsigned x; volatile LAS unsigned* st; int wave; };
__device__ __forceinline__ XcdBarrier xcd_barrier_post(unsigned* bar, volatile LAS unsigned* st) {
    XcdBarrier b; b.bar = bar; b.x = xb_xcc_id(); b.st = st;
    if (__builtin_amdgcn_readfirstlane(threadIdx.x >> 6) == 0 && fresh_lane() == 0) (void)xb_add(&bar[XB_XCNT(b.x)], 1u);
    return b;
}
__device__ __forceinline__ void xcd_barrier_complete(unsigned* bar, unsigned x, unsigned& nloc, unsigned& nx) {
    const unsigned G = gridDim.x * gridDim.y * gridDim.z;
    unsigned sum, cnt, mine, sp = 0u;
    for (;;) {
        sum = 0u; cnt = 0u; mine = 0u;
#pragma unroll
        for (unsigned j = 0; j < 16; ++j) { const unsigned c = xb_ld(&bar[XB_XCNT(j)]); sum += c; cnt += (c > 0u) ? 1u : 0u; mine = (j == x) ? c : mine; }
        if (sum == G) break;
        __builtin_amdgcn_s_sleep(1);
        if ((++sp & 255u) == 0u) { if (xb_ld(&bar[XB_TMO])) break; if (sp > XB_SPIN_CAP) { atomicAdd(&bar[XB_TMO], 1u); break; } }
    }
    nloc = mine > 0u ? mine : 1u; nx = cnt > 0u ? cnt : 1u;
}
__device__ __forceinline__ void xcd_barrier(const XcdBarrier& b) {
    asm volatile("s_waitcnt vmcnt(0)" ::: "memory");
    __syncthreads();
    if (b.wave == 0 && fresh_lane() == 0) {
        unsigned* bar = b.bar;
        __builtin_amdgcn_s_waitcnt(0);
        unsigned nloc = b.st[0], nx = b.st[1];
        if (nloc == 0u) { xcd_barrier_complete(bar, b.x, nloc, nx); b.st[0] = nloc; b.st[1] = nx; }
        const unsigned old = xb_add(&bar[XB_XSUB(b.x)], 1u);
        const unsigned gen = old / nloc;
        if (old + 1u == (gen + 1u) * nloc) {
            __builtin_amdgcn_fence(__ATOMIC_RELEASE, "agent");
            asm volatile("s_waitcnt vmcnt(0)" ::: "memory");
            const unsigned og = xb_add(&bar[XB_TOP], 1u);
            const unsigned tg = og / nx;
            if (og + 1u == (tg + 1u) * nx) xb_add(&bar[XB_TOPGEN], 1u);
            else XB_SPIN(xb_ld(&bar[XB_TOPGEN]) == tg, bar);
            __builtin_amdgcn_fence(__ATOMIC_ACQUIRE, "agent");
            xb_add(&bar[XB_XGEN(b.x)], 1u);
            asm volatile("s_waitcnt vmcnt(0)" ::: "memory");
        } else {
            XB_SPIN(xb_ld(&bar[XB_XGEN(b.x)]) == gen, bar);
            __builtin_amdgcn_fence(__ATOMIC_ACQUIRE, "agent");
            asm volatile("s_waitcnt vmcnt(0)" ::: "memory");
        }
    }
    __syncthreads();
}

constexpr int BM = 256, BK = 64, HALF = 128, HTB = HALF * BK * 2, STAGE_BYTES = 8 * HTB, NXCD = 8, WGM = 8;
__host__ __device__ __forceinline__ int lds_byte(int r, int c) { const int st = (r >> 4) * 2 + (c >> 5), rr = r & 15, cc = c & 31, ob = rr * 64 + cc * 2; return st * 1024 + (ob ^ (((ob >> 9) & 1) << 5)); }
__host__ __device__ __forceinline__ void stage_rc(int b, int& R, int& C) { const int st = b / 1024, sb = b % 1024, swz = sb ^ (((sb >> 9) & 1) << 5); R = (st >> 1) * 16 + swz / 64; C = (st & 1) * 32 + (swz % 64) / 2; }
__host__ __device__ __forceinline__ int perm32(int rho) { const int n = rho >> 4, i = rho & 15; return 8 * (i >> 2) + 4 * n + (i & 3); }
struct Unit { int pm, pn, ex; };
struct DenseOrder {
    int nM, nN, nwg, G, c;
    __device__ void init(int nM_, int nN_, int G_, int c_) { nM = nM_; nN = nN_; nwg = nM * nN; G = G_; c = c_; }
    __device__ bool next(int i, Unit& u) const {
        const long L = (long)i * G + c; if (L >= nwg) return false;
        int wgid = (int)L; { const int q = nwg / NXCD, r = nwg % NXCD, xcd = wgid % NXCD, off = wgid / NXCD; wgid = (xcd < r ? xcd * (q + 1) : r * (q + 1) + (xcd - r) * q) + off; }
        const int nig = WGM * nN, gid = wgid / nig, fm = gid * WGM, gsz = (nM - fm) < WGM ? (nM - fm) : WGM;
        u.pm = fm + ((wgid % nig) % gsz); u.pn = (wgid % nig) / gsz; u.ex = 0; return true;
    }
};
struct DenseAB {
    const char* Ab; const char* Bb; int K; int lda;
    __device__ __forceinline__ const char* a_base(const Unit& u) const { return Ab + (size_t)u.pm * 256 * lda * 2; }
    __device__ __forceinline__ const char* b_base(const Unit& u) const { return Bb + (size_t)u.pn * 256 * K * 2; }
    __device__ __forceinline__ void a_voff(const Unit&, const int (&R)[2], const int (&C)[2], unsigned (&v)[4]) const {
#pragma unroll
        for (int i = 0; i < 2; ++i) { v[i] = (unsigned)(R[i] * lda + C[i]) * 2u; v[2 + i] = (unsigned)((R[i] + HALF) * lda + C[i]) * 2u; } }
};

struct DenseAB8 {
    const char* Ab; const char* Bb; int KB; int ldaB; int pn0;
    __device__ __forceinline__ const char* a_base(const Unit& u) const { return Ab + (size_t)u.pm * 256 * ldaB; }
    __device__ __forceinline__ const char* b_base(const Unit& u) const { return Bb + (size_t)(u.pn - pn0) * 256 * KB; }
    __device__ __forceinline__ void a_voff(const Unit&, const int (&R)[2], const int (&C)[2], unsigned (&v)[4]) const {
#pragma unroll
        for (int i = 0; i < 2; ++i) { v[i] = (unsigned)(R[i] * ldaB + 2 * C[i]); v[2 + i] = (unsigned)((R[i] + HALF) * ldaB + 2 * C[i]); } }
};
struct WindowOrder { DenseOrder d; int pn0;
    __device__ void init(int nM, int nN, int pn0_, int G, int c) { d.init(nM, nN, G, c); pn0 = pn0_; }
    __device__ bool next(int i, Unit& u) const { if (!d.next(i, u)) return false; u.pn += pn0; return true; } };
template <class E_> struct has_mid { template <class T> static constexpr bool test(decltype(T::HAS_MID)*) { return T::HAS_MID; } template <class T> static constexpr bool test(...) { return false; } static constexpr bool value = test<E_>(nullptr); };
template <bool F8 = false, class Epi, class Sched, class AB>
__device__ __forceinline__ void gemm_phase(LAS unsigned char* lds, int KB, const Sched& S, const AB& P, const Epi& E, int wave_) {
    const int wid = wave_, lane = fresh_lane(), tid = wid * 64 + lane, wr = wid >> 2, wc = wid & 3, fr = lane & 15, fq = lane >> 4;
    const int nt = KB / (BK * 2);
    int Rr[2], Cc[2]; unsigned voffB[2];
#pragma unroll
    for (int i = 0; i < 2; ++i) { stage_rc(tid * 16 + i * 8192, Rr[i], Cc[i]); const int Rb = (Rr[i] & ~31) + perm32(Rr[i] & 31); voffB[i] = (unsigned)(Rb * KB + 2 * Cc[i]); }
    const size_t kstep = (size_t)(BK * 2);
    const size_t hstep = (size_t)HALF * KB;
    const unsigned ldsw = (unsigned)wid * 1024u;
    const int aoff = lds_byte(wr * 64 + fr, fq * 8), boff = lds_byte(wc * 32 + fr, fq * 8);
#define PG8_SA(b, h) (((b) * 2 + (h)) * HTB)
#define PG8_SB(b, h) ((4 + (b) * 2 + (h)) * HTB)
#define PG8_STAGE2(bufoff, gbase, v0, v1) do { \
        __builtin_amdgcn_global_load_lds((const unsigned*)((const char*)(gbase) + (v0)), (LAS unsigned*)(lds + (bufoff) + ldsw), 16, 0, 0); \
        __builtin_amdgcn_global_load_lds((const unsigned*)((const char*)(gbase) + (v1)), (LAS unsigned*)(lds + (bufoff) + ldsw + 8192), 16, 0, 0); } while (0)
#define PG8_STAGEB(bufoff, gbase) PG8_STAGE2(bufoff, gbase, voffB[0], voffB[1])
#define PG8_LDA(dst, b, h) do { _Pragma("unroll") for (int m = 0; m < 4; ++m) _Pragma("unroll") for (int k = 0; k < 2; ++k) dst[m][k] = *(const LAS bf16x8*)(lds + PG8_SA(b, h) + aoff + m * 2048 + k * 1024); } while (0)
#define PG8_LDB(dst, b, h) do { _Pragma("unroll") for (int n = 0; n < 2; ++n) _Pragma("unroll") for (int k = 0; k < 2; ++k) dst[n][k] = *(const LAS bf16x8*)(lds + PG8_SB(b, h) + boff + n * 2048 + k * 1024); } while (0)
#define PG8_CAT(x0, x1) __builtin_shufflevector(__builtin_bit_cast(i32x4, x0), __builtin_bit_cast(i32x4, x1), 0, 1, 2, 3, 4, 5, 6, 7)
#define PG8_MMA(ai, bj, At, Bt) do { __builtin_amdgcn_s_setprio(1); _Pragma("unroll") for (int m = 0; m < 4; ++m) _Pragma("unroll") for (int n = 0; n < 2; ++n) { \
        if constexpr (F8) { const i32x8 a8_ = PG8_CAT(Bt[n][0], Bt[n][1]), b8_ = PG8_CAT(At[m][0], At[m][1]);   \
            asm volatile("v_mfma_f32_16x16x128_f8f6f4 %0, %1, %2, %0" : "+v"(acc[ai][bj][m][n]) : "v"(a8_), "v"(b8_)); }     \
        else { _Pragma("unroll") for (int k = 0; k < 2; ++k) acc[ai][bj][m][n] = __builtin_amdgcn_mfma_f32_16x16x32_bf16(Bt[n][k], At[m][k], acc[ai][bj][m][n], 0, 0, 0); } } \
        __builtin_amdgcn_s_setprio(0); } while (0)
#define PG8_WAIT_V(n) asm volatile("s_waitcnt vmcnt(" #n ")" ::: "memory")
#define PG8_WAIT_L(n) asm volatile("s_waitcnt lgkmcnt(" #n ")" ::: "memory")
#define PG8_BAR __builtin_amdgcn_s_barrier()
#define PG8_SCHED __builtin_amdgcn_sched_barrier(0)
    Unit cur, nxt; int ui = 0;
    if (!S.next(0, cur)) return;
    f32x4 acc[2][2][4][2];
#pragma unroll
    for (int a = 0; a < 2; ++a)
#pragma unroll
        for (int b = 0; b < 2; ++b)
#pragma unroll
            for (int m = 0; m < 4; ++m)
#pragma unroll
                for (int n = 0; n < 2; ++n) acc[a][b][m][n] = (f32x4){0.f, 0.f, 0.f, 0.f};
    bf16x8 At[4][2], B0[2][2], B1[2][2];
    const int f8scale = 0x7f7f7f7f;
    const char* cA = P.a_base(cur); const char* cB = P.b_base(cur);
    unsigned cvo[4], nvo[4];
    P.a_voff(cur, Rr, Cc, cvo);
    PG8_STAGEB(PG8_SB(0, 0), cB); PG8_STAGEB(PG8_SB(0, 1), cB + hstep); PG8_STAGE2(PG8_SA(0, 0), cA, cvo[0], cvo[1]); PG8_STAGE2(PG8_SA(0, 1), cA, cvo[2], cvo[3]);
    if (wr == 1) PG8_BAR;
    PG8_WAIT_V(2); PG8_BAR;
    PG8_STAGEB(PG8_SB(1, 0), cB + kstep); PG8_STAGE2(PG8_SA(1, 0), cA + kstep, cvo[0], cvo[1]); PG8_STAGEB(PG8_SB(1, 1), cB + hstep + kstep);
    PG8_WAIT_V(6); PG8_BAR;
    for (;;) {
        const bool has_next = S.next(ui + 1, nxt);
        const char* nA = cA; const char* nB = cB;
#pragma unroll
        for (int i = 0; i < 4; ++i) nvo[i] = cvo[i];
        if (has_next) { nA = P.a_base(nxt); nB = P.b_base(nxt); P.a_voff(nxt, Rr, Cc, nvo); }
        for (int t = 0; t < nt; t += 2) {
            if constexpr (has_mid<Epi>::value) { if (t == nt / 2) { Epi& Em = const_cast<Epi&>(E); Em.mid(acc, cur, wr, wc, fr, fq); } }
            const bool last = (t == nt - 2);
            const char* a1 = cA + (size_t)(t + 1) * kstep;
            const char* a2 = last ? nA : cA + (size_t)(t + 2) * kstep; const char* b2 = last ? nB : cB + (size_t)(t + 2) * kstep;
            const char* a3 = a2 + kstep; const char* b3 = b2 + kstep;
            const unsigned x0 = last ? nvo[0] : cvo[0], x1 = last ? nvo[1] : cvo[1], x2 = last ? nvo[2] : cvo[2], x3 = last ? nvo[3] : cvo[3];
            PG8_LDB(B0, 0, 0); PG8_LDB(B1, 0, 1); PG8_SCHED; PG8_LDA(At, 0, 0); PG8_STAGE2(PG8_SA(1, 1), a1, cvo[2], cvo[3]);
            PG8_WAIT_V(8); PG8_WAIT_L(0); PG8_BAR; PG8_MMA(0, 0, At, B0); PG8_MMA(0, 1, At, B1); PG8_BAR; PG8_SCHED;
            PG8_LDA(At, 0, 1); PG8_STAGEB(PG8_SB(0, 0), b2); PG8_STAGEB(PG8_SB(0, 1), b2 + hstep); PG8_STAGE2(PG8_SA(0, 0), a2, x0, x1);
            PG8_WAIT_V(8); PG8_WAIT_L(0); PG8_BAR; PG8_MMA(1, 0, At, B0); PG8_MMA(1, 1, At, B1); PG8_BAR; PG8_SCHED;
            PG8_LDB(B0, 1, 0); PG8_LDB(B1, 1, 1); PG8_SCHED; PG8_LDA(At, 1, 0); PG8_STAGE2(PG8_SA(0, 1), a2, x2, x3);
            PG8_WAIT_V(8); PG8_WAIT_L(0); PG8_BAR; PG8_MMA(0, 0, At, B0); PG8_MMA(0, 1, At, B1); PG8_BAR; PG8_SCHED;
            PG8_LDA(At, 1, 1); PG8_STAGEB(PG8_SB(1, 0), b3); PG8_STAGEB(PG8_SB(1, 1), b3 + hstep); PG8_STAGE2(PG8_SA(1, 0), a3, x0, x1);
            PG8_WAIT_V(8); PG8_WAIT_L(0); PG8_BAR; PG8_MMA(1, 0, At, B0); PG8_MMA(1, 1, At, B1); PG8_BAR; PG8_SCHED;
        }
        if (wr == 0) PG8_BAR;
        E(acc, cur, wr, wc, fr, fq);
        if (!has_next) break;
#pragma unroll
        for (int a = 0; a < 2; ++a)
#pragma unroll
            for (int b = 0; b < 2; ++b)
#pragma unroll
                for (int m = 0; m < 4; ++m)
#pragma unroll
                    for (int n = 0; n < 2; ++n) acc[a][b][m][n] = (f32x4){0.f, 0.f, 0.f, 0.f};
        cur = nxt; cA = nA; cB = nB; ++ui;
#pragma unroll
        for (int i = 0; i < 4; ++i) cvo[i] = nvo[i];
        if (wr == 1) PG8_BAR;
    }
    PG8_WAIT_V(0);
    PG8_BAR;
#undef PG8_SA
#undef PG8_SB
#undef PG8_STAGE2
#undef PG8_STAGEB
#undef PG8_LDA
#undef PG8_LDB
#undef PG8_MMA
#undef PG8_CAT
#undef PG8_WAIT_V
#undef PG8_WAIT_L
#undef PG8_BAR
#undef PG8_SCHED
}

struct Frame {
    LAS unsigned char* lds; volatile LAS unsigned* MISC; unsigned* ctl;
    int wave, vcu, G;
    const float* in[20]; float* out; unsigned char* ws;
};
__device__ __forceinline__ float wave_sum(float v) {
#pragma unroll
    for (int o = 1; o < 64; o <<= 1) v += __shfl_xor(v, o);
    return v;
}

__host__ __device__ __forceinline__ int perm128(int c) { return ((c >> 6) & 1) * 128 + (c >> 7) * 64 + (c & 63); }
__host__ __device__ __forceinline__ int perm64(int c) { return ((c >> 5) & 1) * 128 + (c >> 6) * 32 + (c & 31); }
__host__ __device__ __forceinline__ int win_dest(int n) {
    if (n < 1024) return 0 * 256 + (n >> 8) * 256 + perm128(n & 255);
    if (n < 2048) { n -= 1024; return 4 * 256 + (n >> 8) * 256 + perm128(n & 255); }
    if (n < 3072) { n -= 2048; return 8 * 256 + n; }
    if (n < 4096) { n -= 3072; return 12 * 256 + (n >> 8) * 256 + perm64(n & 255); }
    if (n < 4160) { n -= 4096; return 44 * 256 + (n >> 5) * 128 + (n & 31); }
    if (n < 4176) { n -= 4160; return 44 * 256 + 64 + n; }
    if (n < 5200) { n -= 4176; return 16 * 256 + (n >> 8) * 256 + perm128(n & 255); }
    if (n < 6224) { n -= 5200; return 20 * 256 + (n >> 8) * 256 + perm128(n & 255); }
    if (n < 7248) { n -= 6224; return 24 * 256 + n; }
    if (n < 9296) { n -= 7248; return 28 * 256 + n; }
    n -= 9296; return 36 * 256 + n;
}

template <class DestFn>
__device__ __forceinline__ void p0_transpose_item(const float* W, int K, int N, bf16_t* WT, LAS float* scr, int item, int lane, DestFn dest, int pitch = 0) {
    if (pitch == 0) pitch = K;
    const int nblk = (N + 31) / 32, kb = item / nblk, nb = item % nblk, k0 = 64 * kb, n0 = 32 * nb;
    { const int lr = lane >> 3, lc = 4 * (lane & 7); const bool nok = (n0 + lc) < N;
      const float* wp = W + (size_t)(k0 + lr) * N + n0 + lc; f32x4 t[8];
#pragma unroll
      for (int i = 0; i < 8; ++i) t[i] = nok ? *(const f32x4*)(wp + (size_t)(8 * i) * N) : (f32x4){0.f, 0.f, 0.f, 0.f};
#pragma unroll
      for (int i = 0; i < 8; ++i) { LAS float* sp = scr + (8 * i + lr) * 33 + lc; sp[0] = t[i][0]; sp[1] = t[i][1]; sp[2] = t[i][2]; sp[3] = t[i][3]; } }
    LDS_WAIT(); asm volatile("" ::: "memory");
    const int c = lane & 7;
#pragma unroll
    for (int j = 0; j < 4; ++j) { const int n = (lane >> 3) + 8 * j; const LAS float* s = scr + (8 * c) * 33 + n;
        u32x4 o; o.x = cvt_pk_bf16(s[0 * 33], s[1 * 33]); o.y = cvt_pk_bf16(s[2 * 33], s[3 * 33]); o.z = cvt_pk_bf16(s[4 * 33], s[5 * 33]); o.w = cvt_pk_bf16(s[6 * 33], s[7 * 33]);
        if (n0 + n < N) *(GAS u32x4*)(WT + (size_t)dest(n0 + n) * pitch + k0 + 8 * c) = o; }
    LDS_WAIT(); asm volatile("" ::: "memory");
}
struct DestId { __device__ __forceinline__ int operator()(int n) const { return n; } };
struct DestWin { __device__ __forceinline__ int operator()(int n) const { return win_dest(n); } };
struct DestWin8 { __device__ __forceinline__ int operator()(int n) const { return n >= GATE_COL0 ? win_dest(n) - GATE_TILE0 * 256 : -1; } };
template <class DestFn>
__device__ __forceinline__ void p0_transpose_item_f8(const float* W, int K, int N, unsigned char* WT, LAS float* scr, int item, int lane, DestFn dest, int pitch = 0) {
    if (pitch == 0) pitch = K;
    const int nblk = (N + 31) / 32, kb = item / nblk, nb = item % nblk, k0 = 64 * kb, n0 = 32 * nb;
    { const int lr = lane >> 3, lc = 4 * (lane & 7); const bool nok = (n0 + lc) < N;
      const float* wp = W + (size_t)(k0 + lr) * N + n0 + lc; f32x4 t[8];
#pragma unroll
      for (int i = 0; i < 8; ++i) t[i] = nok ? *(const f32x4*)(wp + (size_t)(8 * i) * N) : (f32x4){0.f, 0.f, 0.f, 0.f};
#pragma unroll
      for (int i = 0; i < 8; ++i) { LAS float* sp = scr + (8 * i + lr) * 33 + lc; sp[0] = t[i][0]; sp[1] = t[i][1]; sp[2] = t[i][2]; sp[3] = t[i][3]; } }
    LDS_WAIT(); asm volatile("" ::: "memory");
    const int c = lane & 7;
#pragma unroll
    for (int j = 0; j < 4; ++j) { const int n = (lane >> 3) + 8 * j; const LAS float* s = scr + (8 * c) * 33 + n;
        u32x2 o; o.x = cvt4_fp8(s[0 * 33] * F8_WSCALE, s[1 * 33] * F8_WSCALE, s[2 * 33] * F8_WSCALE, s[3 * 33] * F8_WSCALE); o.y = cvt4_fp8(s[4 * 33] * F8_WSCALE, s[5 * 33] * F8_WSCALE, s[6 * 33] * F8_WSCALE, s[7 * 33] * F8_WSCALE);
        const int dr = (n0 + n < N) ? dest(n0 + n) : -1;
        if (dr >= 0) *(GAS u32x2*)(WT + (size_t)dr * pitch + k0 + 8 * c) = o; }
    LDS_WAIT(); asm volatile("" ::: "memory");
}

__device__ __forceinline__ void zero_row_bf16(bf16_t* p, int nelem, int lane) {
    for (int i = lane * 8; i < nelem; i += 512) *(GAS u32x4*)(p + i) = (u32x4){0u, 0u, 0u, 0u};
}

__device__ __forceinline__ void p0_prologue(Frame& F) {
    const int lane_ = fresh_lane();
    LAS float* scr = (LAS float*)(F.lds + RING_OFF + F.wave * 16384);
    const int gw = F.vcu * NWAVES + F.wave, NGW = F.G * NWAVES;
    const float* x = F.in[0]; const float* meta = F.in[1]; const float* g_mix = F.in[2]; const float* w_in = F.in[3];
    const float* w_up_a = F.in[9]; const float* w_up_b = F.in[10]; const float* w_out = F.in[11]; const float* g_ffn = F.in[12]; const float* w_router = F.in[13];
    unsigned char* ws = F.ws;
    const float* w1 = F.in[15]; const float* w2 = F.in[17];
    constexpr int I_IN = (D / 64) * ((DIN + 31) / 32), I_UP = (1024 / 64) * (D / 32), I_OUT = (D / 64) * (D / 32), I_W1 = (D / 64) * (4096 / 32), I_W2 = (DFF / 64) * (D / 32);
    constexpr int NITEMS = I_IN;
    for (int it = gw; it < NITEMS; it += NGW) {
        int r = it;
        if (r < I_IN) { const int n0_ = 32 * (r % ((DIN + 31) / 32));
            if (n0_ < GATE_COL0) p0_transpose_item(w_in, D, DIN, (bf16_t*)(ws + WS_WIN), scr, r, lane_, DestWin());
            if (n0_ + 31 >= GATE_COL0) p0_transpose_item_f8(w_in, D, DIN, ws + WS_WIN8, scr, r, lane_, DestWin8());
            continue; } r -= I_IN;
    }
    {
        constexpr int J0 = 176, J1 = J0 + 240, J2 = J1 + 4 * 96, J3 = J2 + 96;
        for (int j = gw; j < J3; j += NGW) {
            if (j < J0) { int s = j; int slot = s < 32 ? 32 + s : (s < 32 + 48 ? 80 + (s - 32) : 160 + (s - 80)); zero_row_bf16((bf16_t*)(ws + WS_WIN) + (size_t)(44 * 256 + slot) * D, D, lane_); }
            else if (j < J1) { zero_row_bf16((bf16_t*)(ws + WS_HN) + (size_t)(NX + NMETA + (j - J0)) * D, D, lane_); }
            else if (j < J2) { const int q = j - J1, which = q / 96, rr = q % 96, b = rr / 48, p = T + rr % 48;
                const size_t base = which == 0 ? WS_KA : which == 1 ? WS_VA : which == 2 ? WS_KB : WS_VB;
                zero_row_bf16((bf16_t*)(ws + base) + ((size_t)b * TP + p) * 1024, 1024, lane_); }
            else { const int rr = j - J2, b = rr / 48, p = T + rr % 48; zero_row_bf16((bf16_t*)(ws + WS_KI) + ((size_t)b * TP + p) * 64, 64, lane_); }
        }
    }
    {
        const int gt = gw * 64 + lane_, NGT = NGW * 64;
        f32x2* rope = (f32x2*)(ws + WS_ROPE); f32x2* ropei = (f32x2*)(ws + WS_ROPEI);
        for (int i = gt; i < T * 64; i += NGT) { const int pos = i >> 6, fi = i & 63; const double ang = (double)pos * pow(10000.0, -(double)fi / 64.0); rope[i] = (f32x2){(float)cos(ang), (float)sin(ang)}; }
        for (int i = gt; i < T * 32; i += NGT) { const int pos = i >> 5, fi = i & 31; const double ang = (double)pos * pow(10000.0, -(double)fi / 32.0); ropei[i] = (f32x2){(float)cos(ang), (float)sin(ang)}; }
        bf16_t* wrh = (bf16_t*)(ws + WS_WR); bf16_t* wrl = wrh + NE * D;
        for (int i = gt; i < NE * D; i += NGT) { const int e = i / D, k = i % D; const float v = g_ffn[k] * w_router[(size_t)k * NE + e]; const unsigned h = f2bf(v); const float hv = __uint_as_float(h << 16);
            const int s_ = k >> 5, ln_ = 16 * ((k >> 3) & 3) + (e & 15), f_ = 2 * (e >> 4); const size_t o_ = ((size_t)(s_ * 4 + f_) * 64 + ln_) * 8 + (k & 7);
            wrh[o_] = (bf16_t)h; wrh[o_ + 512] = (bf16_t)f2bf(v - hv); }
    }
    for (int r = gw; r < NX + NMETA; r += NGW) {
        const float* src = r < NX ? x + (size_t)r * D : meta + (size_t)(r - NX) * D;
        const GAS f32x4* xr = (const GAS f32x4*)src + lane_; const GAS f32x4* gr = (const GAS f32x4*)g_mix + lane_;
        f32x4 v[8]; float s = 0.f;
#pragma unroll
        for (int j = 0; j < 8; ++j) { v[j] = xr[64 * j]; s += (v[j].x * v[j].x + v[j].y * v[j].y) + (v[j].z * v[j].z + v[j].w * v[j].w); }
        const float rs = 1.0f / sqrtf(wave_sum(s) * (1.f / D) + EPS);
        GAS u32x2* o8 = (GAS u32x2*)((bf16_t*)(ws + WS_HN) + (size_t)r * D) + lane_;
        GAS unsigned* o4 = (GAS unsigned*)(ws + WS_HN8 + (size_t)r * D) + lane_;
#pragma unroll
        for (int j = 0; j < 8; ++j) { const f32x4 g = gr[64 * j]; const float y0 = v[j].x * rs * g.x, y1 = v[j].y * rs * g.y, y2 = v[j].z * rs * g.z, y3 = v[j].w * rs * g.w;
            u32x2 w; w.x = cvt_pk_bf16(y0, y1); w.y = cvt_pk_bf16(y2, y3); o8[64 * j] = w; o4[64 * j] = cvt4_fp8(y0, y1, y2, y3); }
    }
}

struct EpiInProj {
    unsigned char* ws; float sc;
    template <int MODE>
    __device__ __forceinline__ void store_tile(const f32x4 (&acc)[2][2][4][2], bf16_t* dst, int ld, int colbase, size_t rowbase, int nvalid, int pos0, size_t dupoff, int wr, int wc, int fr, int fq) const {
        const f32x2* rope = (const f32x2*)(ws + WS_ROPE); const f32x2* ropei = (const f32x2*)(ws + WS_ROPEI);
#pragma unroll
        for (int ai = 0; ai < 2; ++ai)
#pragma unroll
            for (int m = 0; m < 4; ++m) {
                const int tr = ai * HALF + wr * 64 + m * 16 + fr;
                if (tr < nvalid) {
                    bf16_t* rowp = dst + (rowbase + tr) * (size_t)ld + colbase;
                    if (MODE == 0 || MODE == 1) {
#pragma unroll
                        for (int bj = 0; bj < 2; ++bj) { f32x4 v0 = acc[ai][bj][m][0] * sc, v1 = acc[ai][bj][m][1] * sc;
                            if (MODE == 1) {
#pragma unroll
                                for (int j = 0; j < 4; ++j) { v0[j] = __builtin_amdgcn_rcpf(1.f + __builtin_amdgcn_exp2f(-1.4426950408889634f * v0[j])); v1[j] = __builtin_amdgcn_rcpf(1.f + __builtin_amdgcn_exp2f(-1.4426950408889634f * v1[j])); } }
                            u32x4 w; w.x = cvt_pk_bf16(v0[0], v0[1]); w.y = cvt_pk_bf16(v0[2], v0[3]); w.z = cvt_pk_bf16(v1[0], v1[1]); w.w = cvt_pk_bf16(v1[2], v1[3]);
                            *(u32x4*)(rowp + bj * HALF + wc * 32 + 8 * fq) = w; if (dupoff) *(u32x4*)(rowp + dupoff + bj * HALF + wc * 32 + 8 * fq) = w; }
                    } else {
                        const int pos = pos0 + tr;
                        const int i0 = MODE == 2 ? (wc & 1) * 32 + 8 * fq : 8 * fq;
                        const int col = MODE == 2 ? (wc >> 1) * 128 + i0 : wc * 64 + i0;
                        const int hw = MODE == 2 ? 64 : 32;
                        const f32x4* tp = (const f32x4*)((MODE == 2 ? rope + (size_t)pos * 64 : ropei + (size_t)pos * 32) + i0);
                        const f32x4 t0 = tp[0], t1 = tp[1], t2 = tp[2], t3 = tp[3];
                        const f32x4 a0 = acc[ai][0][m][0], a1 = acc[ai][0][m][1], b0 = acc[ai][1][m][0], b1 = acc[ai][1][m][1];
                        float y1[8], y2[8];
                        y1[0] = a0[0] * t0[0] - b0[0] * t0[1]; y2[0] = b0[0] * t0[0] + a0[0] * t0[1];
                        y1[1] = a0[1] * t0[2] - b0[1] * t0[3]; y2[1] = b0[1] * t0[2] + a0[1] * t0[3];
                        y1[2] = a0[2] * t1[0] - b0[2] * t1[1]; y2[2] = b0[2] * t1[0] + a0[2] * t1[1];
                        y1[3] = a0[3] * t1[2] - b0[3] * t1[3]; y2[3] = b0[3] * t1[2] + a0[3] * t1[3];
                        y1[4] = a1[0] * t2[0] - b1[0] * t2[1]; y2[4] = b1[0] * t2[0] + a1[0] * t2[1];
                        y1[5] = a1[1] * t2[2] - b1[1] * t2[3]; y2[5] = b1[1] * t2[2] + a1[1] * t2[3];
                        y1[6] = a1[2] * t3[0] - b1[2] * t3[1]; y2[6] = b1[2] * t3[0] + a1[2] * t3[1];
                        y1[7] = a1[3] * t3[2] - b1[3] * t3[3]; y2[7] = b1[3] * t3[2] + a1[3] * t3[3];
                        u32x4 w1, w2; w1.x = cvt_pk_bf16(y1[0], y1[1]); w1.y = cvt_pk_bf16(y1[2], y1[3]); w1.z = cvt_pk_bf16(y1[4], y1[5]); w1.w = cvt_pk_bf16(y1[6], y1[7]);
                        w2.x = cvt_pk_bf16(y2[0], y2[1]); w2.y = cvt_pk_bf16(y2[2], y2[3]); w2.z = cvt_pk_bf16(y2[4], y2[5]); w2.w = cvt_pk_bf16(y2[6], y2[7]);
                        *(u32x4*)(rowp + col) = w1; *(u32x4*)(rowp + col + hw) = w2; if (dupoff) { *(u32x4*)(rowp + dupoff + col) = w1; *(u32x4*)(rowp + dupoff + col + hw) = w2; }
                    }
                }
                asm volatile("" ::: "memory");
            }
    }
    __device__ __forceinline__ void operator()(const f32x4 (&acc)[2][2][4][2], const Unit& u, int wr, int wc, int fr, int fq) const {
        const int pn = u.pn, pm = u.pm;
        const int sec = pn < 28 ? (pn >> 2) : (pn < 36 ? 7 : (pn < 44 ? 8 : 9));
        const int mode = (sec == 2 || sec == 6) ? 0 : ((sec == 7 || sec == 8) ? 1 : ((sec == 3 || sec == 9) ? 3 : 2));
        const int kt = (sec == 1 || sec == 2 || sec == 5 || sec == 6 || sec == 9) ? 1 : 0;
        const int ld = (sec == 7 || sec == 8) ? 2048 : (sec == 9 ? 64 : 1024);
        const int colbase = sec < 7 ? (pn & 3) * 256 : (sec == 7 ? (pn - 28) * 256 : (sec == 8 ? (pn - 36) * 256 : 0));
        const size_t off = sec == 0 ? WS_QA : sec == 1 ? WS_KA : sec == 2 ? WS_VA : sec == 3 ? WS_QI : sec == 4 ? WS_QB : sec == 5 ? WS_KB : sec == 6 ? WS_VB : sec == 7 ? WS_GA : sec == 8 ? WS_GB : WS_KI;
        if (sec == 9 && pm < 64 && wc == 2 && fq < 2) {
            float* WI = (float*)(ws + WS_WI);
#pragma unroll
            for (int ai = 0; ai < 2; ++ai)
#pragma unroll
                for (int m = 0; m < 4; ++m) { const int r = pm * 256 + ai * HALF + wr * 64 + m * 16 + fr;
                    *(f32x4*)(WI + (size_t)r * 16 + 8 * fq) = acc[ai][0][m][0] * (1.0f / 32.0f); *(f32x4*)(WI + (size_t)r * 16 + 8 * fq + 4) = acc[ai][0][m][1] * (1.0f / 32.0f); }
        }
        const bool meta = pm >= 64;
        const bool active = (sec != 9 || wc == 0) && (kt != 0 || !meta);
        bf16_t* dst = (bf16_t*)(ws + off);
        const int pos0 = meta ? 0 : NMETA + (pm & 31) * 256;
        const int nvalid = active ? (meta ? NMETA : 256) : 0;
        const size_t rowbase = meta ? (size_t)0 : (kt ? (size_t)(pm >> 5) * TP + pos0 : (size_t)pm * 256);
        const size_t dupoff = meta ? (size_t)TP * ld : (size_t)0;
        if (mode == 0) store_tile<0>(acc, dst, ld, colbase, rowbase, nvalid, pos0, dupoff, wr, wc, fr, fq);
        else if (mode == 1) store_tile<1>(acc, dst, ld, colbase, rowbase, nvalid, pos0, dupoff, wr, wc, fr, fq);
        else if (mode == 2) store_tile<2>(acc, dst, ld, colbase, rowbase, nvalid, pos0, dupoff, wr, wc, fr, fq);
        else store_tile<3>(acc, dst, ld, colbase, rowbase, nvalid, pos0, dupoff, wr, wc, fr, fq);
    }
};


struct EpiUp {
    static constexpr bool HAS_MID = true;
    const bf16_t* GA; const bf16_t* GB; unsigned char* MG; float msc, esc;
    __device__ __forceinline__ void mid(f32x4 (&acc)[2][2][4][2], const Unit& u, int wr, int wc, int fr, int fq) const {
        asm volatile("" : "+v"(fr), "+v"(fq));
#pragma unroll
        for (int ai = 0; ai < 2; ++ai)
#pragma unroll
            for (int m = 0; m < 4; ++m) { const size_t ro = (size_t)(u.pm * 256 + ai * HALF + wr * 64 + m * 16 + fr) * D + u.pn * 256 + wc * 32 + 8 * fq;
#pragma unroll
                for (int bj = 0; bj < 2; ++bj) { const u32x4 a = *(const u32x4*)(GA + ro + bj * HALF), b = *(const u32x4*)(GB + ro + bj * HALF);
                    f32x4& v0 = acc[ai][bj][m][0]; f32x4& v1 = acc[ai][bj][m][1];
                    v0[0] *= msc * __uint_as_float(a.x << 16) * __builtin_amdgcn_rcpf(__uint_as_float(b.x << 16)); v0[1] *= msc * __uint_as_float(a.x & 0xffff0000u) * __builtin_amdgcn_rcpf(__uint_as_float(b.x & 0xffff0000u));
                    v0[2] *= msc * __uint_as_float(a.y << 16) * __builtin_amdgcn_rcpf(__uint_as_float(b.y << 16)); v0[3] *= msc * __uint_as_float(a.y & 0xffff0000u) * __builtin_amdgcn_rcpf(__uint_as_float(b.y & 0xffff0000u));
                    v1[0] *= msc * __uint_as_float(a.z << 16) * __builtin_amdgcn_rcpf(__uint_as_float(b.z << 16)); v1[1] *= msc * __uint_as_float(a.z & 0xffff0000u) * __builtin_amdgcn_rcpf(__uint_as_float(b.z & 0xffff0000u));
                    v1[2] *= msc * __uint_as_float(a.w << 16) * __builtin_amdgcn_rcpf(__uint_as_float(b.w << 16)); v1[3] *= msc * __uint_as_float(a.w & 0xffff0000u) * __builtin_amdgcn_rcpf(__uint_as_float(b.w & 0xffff0000u)); }
                asm volatile("" ::: "memory"); }
    }
    __device__ __forceinline__ void operator()(const f32x4 (&acc)[2][2][4][2], const Unit& u, int wr, int wc, int fr, int fq) const {
#pragma unroll
        for (int ai = 0; ai < 2; ++ai)
#pragma unroll
            for (int m = 0; m < 4; ++m) { const size_t ro = (size_t)(u.pm * 256 + ai * HALF + wr * 64 + m * 16 + fr) * D + u.pn * 256 + wc * 32 + 8 * fq;
#pragma unroll
                for (int bj = 0; bj < 2; ++bj) { const u32x4 g = *(const u32x4*)(GB + ro + bj * HALF);
                    const f32x4 v0 = acc[ai][bj][m][0] * esc, v1 = acc[ai][bj][m][1] * esc;
                    u32x2 w;
                    w.x = cvt4_fp8(v0[0] * __uint_as_float(g.x << 16), v0[1] * __uint_as_float(g.x & 0xffff0000u), v0[2] * __uint_as_float(g.y << 16), v0[3] * __uint_as_float(g.y & 0xffff0000u));
                    w.y = cvt4_fp8(v1[0] * __uint_as_float(g.z << 16), v1[1] * __uint_as_float(g.z & 0xffff0000u), v1[2] * __uint_as_float(g.w << 16), v1[3] * __uint_as_float(g.w & 0xffff0000u));
                    *(u32x2*)(MG + ro + bj * HALF) = w; }
                asm volatile("" ::: "memory"); }
    }
};
struct EpiOut {
    const float* X; bf16_t* H1; float sc;
    __device__ __forceinline__ void operator()(const f32x4 (&acc)[2][2][4][2], const Unit& u, int wr, int wc, int fr, int fq) const {
#pragma unroll
        for (int ai = 0; ai < 2; ++ai)
#pragma unroll
            for (int m = 0; m < 4; ++m) { const size_t ro = (size_t)(u.pm * 256 + ai * HALF + wr * 64 + m * 16 + fr) * D + u.pn * 256 + wc * 32 + 8 * fq;
#pragma unroll
                for (int bj = 0; bj < 2; ++bj) { const f32x4 x0 = *(const f32x4*)(X + ro + bj * HALF), x1 = *(const f32x4*)(X + ro + bj * HALF + 4);
                    const f32x4 v0 = x0 + acc[ai][bj][m][0] * sc, v1 = x1 + acc[ai][bj][m][1] * sc;
                    u32x4 w; w.x = cvt_pk_bf16(v0[0], v0[1]); w.y = cvt_pk_bf16(v0[2], v0[3]); w.z = cvt_pk_bf16(v1[0], v1[1]); w.w = cvt_pk_bf16(v1[2], v1[3]);
                    *(u32x4*)(H1 + ro + bj * HALF) = w; }
                asm volatile("" ::: "memory"); }
    }
};

__device__ __forceinline__ void moe_tables(Frame& F) {
    volatile LAS int* tb = (volatile LAS int*)(F.lds + MOE_TB_OFF); volatile LAS int* cnt = (volatile LAS int*)(F.lds + MOE_CNT_OFF);
    const int tid_ = F.wave * 64 + fresh_lane();
    __syncthreads();
    if (tid_ < NE) cnt[tid_] = (int)__hip_atomic_load(F.ctl + CW_CNT + 64 * tid_, __ATOMIC_RELAXED, __HIP_MEMORY_SCOPE_AGENT);
    __syncthreads();
    if (tid_ == 0) { int run = 0; for (int e = 0; e < NE; ++e) { tb[e] = run; run += (cnt[e] + 255) >> 8; } tb[NE] = run < MAXT ? run : MAXT; }
    __syncthreads();
}
struct MoeOrder {
    int G, c, nPN; const volatile LAS int* tb;
    __device__ bool next(int i, Unit& u) const {
        const int L = i * G + c, TT = tb[NE]; if (L >= TT * nPN) return false;
        const int t = L / nPN; u.pm = t; u.pn = L - t * nPN; int e = 0;
        for (int j = 1; j < NE; ++j) e += (tb[j] <= t) ? 1 : 0;
        u.ex = e; return true;
    }
};
struct MoeAB1 {
    const char* HB; const char* W1T; const int* lists; const volatile LAS int* tb; const volatile LAS int* cnt;
    __device__ __forceinline__ const char* a_base(const Unit&) const { return HB; }
    __device__ __forceinline__ const char* b_base(const Unit& u) const { return W1T + ((size_t)u.ex * 4096 + (size_t)u.pn * 256) * D; }
    __device__ __forceinline__ void a_voff(const Unit& u, const int (&R)[2], const int (&C)[2], unsigned (&v)[4]) const {
        const int base = (u.pm - tb[u.ex]) * 256, n = cnt[u.ex]; const int* le = lists + (size_t)u.ex * MAXL;
#pragma unroll
        for (int h = 0; h < 2; ++h)
#pragma unroll
            for (int i = 0; i < 2; ++i) { const int row = base + R[i] + HALF * h; const int tok = le[row < n ? row : 0]; v[2 * h + i] = (unsigned)(tok * D + 2 * C[i]); }
    }
};
struct MoeAB2 {
    const char* Gb; const char* W2T;
    __device__ __forceinline__ const char* a_base(const Unit& u) const { return Gb + (size_t)u.pm * 256 * DFF; }
    __device__ __forceinline__ const char* b_base(const Unit& u) const { return W2T + ((size_t)u.ex * D + (size_t)u.pn * 256) * DFF; }
    __device__ __forceinline__ void a_voff(const Unit&, const int (&R)[2], const int (&C)[2], unsigned (&v)[4]) const {
#pragma unroll
        for (int i = 0; i < 2; ++i) { v[i] = (unsigned)(R[i] * DFF + 2 * C[i]); v[2 + i] = (unsigned)((R[i] + HALF) * DFF + 2 * C[i]); } }
};
struct EpiMoe1 {
    const float* b1; unsigned char* G;
    __device__ __forceinline__ void operator()(const f32x4 (&acc)[2][2][4][2], const Unit& u, int wr, int wc, int fr, int fq) const {
        const int col0 = u.pn * 256 + wc * 32 + 8 * fq; const float* bp = b1 + (size_t)u.ex * 4096 + col0;
        const f32x4 ba0 = *(const f32x4*)(bp), ba1 = *(const f32x4*)(bp + 4), bb0 = *(const f32x4*)(bp + HALF), bb1 = *(const f32x4*)(bp + HALF + 4);
#pragma unroll
        for (int ai = 0; ai < 2; ++ai)
#pragma unroll
            for (int m = 0; m < 4; ++m) { unsigned char* rowp = G + (size_t)(u.pm * 256 + ai * HALF + wr * 64 + m * 16 + fr) * DFF + (col0 >> 1);
#pragma unroll
                for (int bj = 0; bj < 2; ++bj) { const f32x4 v0 = acc[ai][bj][m][0] * F8_WINV + (bj ? bb0 : ba0), v1 = acc[ai][bj][m][1] * F8_WINV + (bj ? bb1 : ba1);
                    float o[4];
                    const float ga[4] = {v0[0], v0[2], v1[0], v1[2]}, li[4] = {v0[1], v0[3], v1[1], v1[3]};
#pragma unroll
                    for (int j = 0; j < 4; ++j) { const float a = fminf(ga[j], 7.0f), l = fminf(fmaxf(li[j], -7.0f), 7.0f);
                        const float sg = __builtin_amdgcn_rcpf(1.0f + __builtin_amdgcn_exp2f(-1.702f * 1.4426950408889634f * a)); o[j] = (a * sg) * (l + 1.0f); }
                    *(unsigned*)(rowp + bj * (HALF / 2)) = cvt4_fp8(o[0], o[1], o[2], o[3]); }
                asm volatile("" ::: "memory"); }
    }
};
struct EpiMoe2 {
    const float* b2; bf16_t* Y;
    __device__ __forceinline__ void operator()(const f32x4 (&acc)[2][2][4][2], const Unit& u, int wr, int wc, int fr, int fq) const {
        const int col0 = u.pn * 256 + wc * 32 + 8 * fq; const float* bp = b2 + (size_t)u.ex * D + col0;
        const f32x4 ba0 = *(const f32x4*)(bp), ba1 = *(const f32x4*)(bp + 4), bb0 = *(const f32x4*)(bp + HALF), bb1 = *(const f32x4*)(bp + HALF + 4);
#pragma unroll
        for (int ai = 0; ai < 2; ++ai)
#pragma unroll
            for (int m = 0; m < 4; ++m) { bf16_t* rowp = Y + (size_t)(u.pm * 256 + ai * HALF + wr * 64 + m * 16 + fr) * D + col0;
#pragma unroll
                for (int bj = 0; bj < 2; ++bj) { const f32x4 v0 = acc[ai][bj][m][0] * F8_WINV + (bj ? bb0 : ba0), v1 = acc[ai][bj][m][1] * F8_WINV + (bj ? bb1 : ba1);
                    u32x4 w; w.x = cvt_pk_bf16(v0[0], v0[1]); w.y = cvt_pk_bf16(v0[2], v0[3]); w.z = cvt_pk_bf16(v1[0], v1[1]); w.w = cvt_pk_bf16(v1[2], v1[3]);
                    *(u32x4*)(rowp + bj * HALF) = w; }
                asm volatile("" ::: "memory"); }
    }
};

typedef float f32x4v __attribute__((ext_vector_type(4)));
__device__ __forceinline__ void router_phase(Frame& F) {
    const int gw = F.vcu * NWAVES + F.wave, NGW = F.G * NWAVES, lane = fresh_lane(), r = lane & 15, q = lane >> 4;
    const bf16_t* H1 = (const bf16_t*)(F.ws + WS_H1); bf16_t* HB = (bf16_t*)(F.ws + WS_HB);
    const bf16_t* wrh = (const bf16_t*)(F.ws + WS_WR); const bf16_t* wrl = wrh + NE * D;
    const float* g_ffn = F.in[12]; const float* b_router = F.in[14];
    float* GATE = (float*)(F.ws + WS_GATE); int* SEI = (int*)(F.ws + WS_SEI); int* LIST = (int*)(F.ws + WS_LIST);
    LAS float* lg = (LAS float*)(F.lds + RING_OFF + F.wave * 16384);
    LAS int* hist = (LAS int*)(F.lds + RING_OFF + 7 * 16384); LAS int* hbase = hist + 32;
    for (int t0 = F.vcu * 4; t0 < NX / 16; t0 += F.G * 4) {
        const int tile = t0 + (F.wave & 3);
        int i0 = -1, i1 = -1, i2 = -1, i3 = -1, q0 = 0, q1 = 0, q2 = 0, q3 = 0; const bool act = F.wave < 4 && lane < 16;
        if (F.wave == 4 && lane < 32) hist[lane] = 0;
        if (F.wave < 4) {
        const int lr = lane >> 4, lc = lane & 15;
        LAS unsigned char* stg = (LAS unsigned char*)lg + 4096;
        LAS float* rsb = lg + 576;
        const bf16_t* hrow = H1 + (size_t)(tile * 16 + lr) * D + 8 * lc;
        f32x4v c0 = {0.f, 0.f, 0.f, 0.f}, c1 = {0.f, 0.f, 0.f, 0.f}; float ssj[4] = {0.f, 0.f, 0.f, 0.f};
#pragma unroll 2
        for (int kb = 0; kb < D / 128; ++kb) {
            u32x4 t[4];
#pragma unroll
            for (int j = 0; j < 4; ++j) t[j] = *(const u32x4*)(hrow + (size_t)(4 * j) * D + 128 * kb);
#pragma unroll
            for (int j = 0; j < 4; ++j) { const u32x4 hw = t[j];
                const float a0 = __uint_as_float(hw.x << 16), a1 = __uint_as_float(hw.x & 0xffff0000u), a2 = __uint_as_float(hw.y << 16), a3 = __uint_as_float(hw.y & 0xffff0000u);
                const float a4 = __uint_as_float(hw.z << 16), a5 = __uint_as_float(hw.z & 0xffff0000u), a6 = __uint_as_float(hw.w << 16), a7 = __uint_as_float(hw.w & 0xffff0000u);
                ssj[j] += (a0 * a0 + a1 * a1) + (a2 * a2 + a3 * a3) + (a4 * a4 + a5 * a5) + (a6 * a6 + a7 * a7);
                *(LAS u32x4*)(stg + (lr + 4 * j) * 272 + 16 * lc) = hw; }
            LDS_WAIT(); asm volatile("" ::: "memory");
#pragma unroll
            for (int ks = 0; ks < 4; ++ks) {
                const bf16x8 ah = *(const LAS bf16x8*)(stg + r * 272 + 64 * ks + 16 * q);
                const bf16_t* wf = wrh + ((size_t)((4 * kb + ks) * 4) * 64 + lane) * 8;
                const bf16x8 bh0 = *(const bf16x8*)(wf), bl0 = *(const bf16x8*)(wf + 512), bh1 = *(const bf16x8*)(wf + 1024), bl1 = *(const bf16x8*)(wf + 1536);
                c0 = __builtin_amdgcn_mfma_f32_16x16x32_bf16(ah, bh0, c0, 0, 0, 0); c0 = __builtin_amdgcn_mfma_f32_16x16x32_bf16(ah, bl0, c0, 0, 0, 0);
                c1 = __builtin_amdgcn_mfma_f32_16x16x32_bf16(ah, bh1, c1, 0, 0, 0); c1 = __builtin_amdgcn_mfma_f32_16x16x32_bf16(ah, bl1, c1, 0, 0, 0);
            }
            LDS_WAIT(); asm volatile("" ::: "memory");
        }
#pragma unroll
        for (int j = 0; j < 4; ++j) { float v = ssj[j]; v += __shfl_xor(v, 1); v += __shfl_xor(v, 2); v += __shfl_xor(v, 4); v += __shfl_xor(v, 8);
            if (lc == 0) rsb[lr + 4 * j] = 1.0f / sqrtf(v * (1.0f / D) + EPS); }
        LDS_WAIT(); asm volatile("" ::: "memory");
        {
            unsigned char* ob = (unsigned char*)HB + (size_t)(tile * 16 + lr) * D + 8 * lc; const float* gp = g_ffn + 8 * lc;
            float rsr[4];
#pragma unroll
            for (int j = 0; j < 4; ++j) rsr[j] = rsb[lr + 4 * j];
#pragma unroll 2
            for (int kb = 0; kb < D / 128; ++kb) { const f32x4 g0 = *(const f32x4*)(gp + 128 * kb), g1 = *(const f32x4*)(gp + 128 * kb + 4);
#pragma unroll
                for (int j = 0; j < 4; ++j) { const u32x4 hw = *(const u32x4*)(hrow + (size_t)(4 * j) * D + 128 * kb); const float rs_ = rsr[j];
                    u32x2 w; w.x = cvt4_fp8(__uint_as_float(hw.x << 16) * rs_ * g0[0], __uint_as_float(hw.x & 0xffff0000u) * rs_ * g0[1], __uint_as_float(hw.y << 16) * rs_ * g0[2], __uint_as_float(hw.y & 0xffff0000u) * rs_ * g0[3]);
                    w.y = cvt4_fp8(__uint_as_float(hw.z << 16) * rs_ * g1[0], __uint_as_float(hw.z & 0xffff0000u) * rs_ * g1[1], __uint_as_float(hw.w << 16) * rs_ * g1[2], __uint_as_float(hw.w & 0xffff0000u) * rs_ * g1[3]);
                    *(u32x2*)(ob + (size_t)(4 * j) * D + 128 * kb) = w; } }
        }
#pragma unroll
        for (int i = 0; i < 4; ++i) { const float rsi = rsb[4 * q + i]; lg[(4 * q + i) * 33 + r] = c0[i] * rsi + b_router[r]; lg[(4 * q + i) * 33 + 16 + r] = c1[i] * rsi + b_router[16 + r]; }
        LDS_WAIT(); asm volatile("" ::: "memory");
        if (lane < 16) {
            const int trow = tile * 16 + lane; float l[NE];
#pragma unroll
            for (int e = 0; e < NE; ++e) l[e] = lg[lane * 33 + e];
            float v0 = 0.f, v1 = 0.f, v2 = 0.f, v3 = 0.f;
#pragma unroll
            for (int k = 0; k < 4; ++k) { int bi = -1; float bv = 0.f;
#pragma unroll
                for (int e = 0; e < NE; ++e) { const bool used = (e == i0) || (e == i1) || (e == i2) || (e == i3); if (!used && (bi < 0 || l[e] > bv)) { bi = e; bv = l[e]; } }
                if (k == 0) { i0 = bi; v0 = bv; } else if (k == 1) { i1 = bi; v1 = bv; } else if (k == 2) { i2 = bi; v2 = bv; } else { i3 = bi; v3 = bv; } }
            const float p1 = __expf(v1 - v0), p2 = __expf(v2 - v0), p3 = __expf(v3 - v0), inv = 1.0f / (1.0f + p1 + p2 + p3);
            *(f32x4*)(GATE + (size_t)trow * 4) = (f32x4){inv, p1 * inv, p2 * inv, p3 * inv};
        }
        }
        LDS_WAIT(); __syncthreads();
        if (act) { q0 = __hip_atomic_fetch_add(hist + i0, 1, __ATOMIC_RELAXED, __HIP_MEMORY_SCOPE_WORKGROUP); q1 = __hip_atomic_fetch_add(hist + i1, 1, __ATOMIC_RELAXED, __HIP_MEMORY_SCOPE_WORKGROUP);
                   q2 = __hip_atomic_fetch_add(hist + i2, 1, __ATOMIC_RELAXED, __HIP_MEMORY_SCOPE_WORKGROUP); q3 = __hip_atomic_fetch_add(hist + i3, 1, __ATOMIC_RELAXED, __HIP_MEMORY_SCOPE_WORKGROUP); }
        LDS_WAIT(); __syncthreads();
        if (F.wave == 4 && lane < 32) { const int c = hist[lane]; hbase[lane] = c > 0 ? (int)atomicAdd(F.ctl + CW_CNT + 64 * lane, (unsigned)c) : 0; }
        LDS_WAIT(); __syncthreads();
        if (act) { const int trow = tile * 16 + lane;
            const int o0 = hbase[i0] + q0, o1 = hbase[i1] + q1, o2 = hbase[i2] + q2, o3 = hbase[i3] + q3;
            LIST[(size_t)i0 * MAXL + o0] = trow; LIST[(size_t)i1 * MAXL + o1] = trow; LIST[(size_t)i2 * MAXL + o2] = trow; LIST[(size_t)i3 * MAXL + o3] = trow;
            typedef int i32x4 __attribute__((ext_vector_type(4)));
            *(i32x4*)(SEI + (size_t)trow * 4) = (i32x4){(i0 << 16) | o0, (i1 << 16) | o1, (i2 << 16) | o2, (i3 << 16) | o3};
        }
        LDS_WAIT(); __syncthreads();
    }
}
__device__ __forceinline__ void final_phase(Frame& F) {
    const int lane_ = fresh_lane();
    const int gw = F.vcu * NWAVES + F.wave, NGW = F.G * NWAVES;
    const bf16_t* H1 = (const bf16_t*)(F.ws + WS_H1); const bf16_t* Y = (const bf16_t*)(F.ws + WS_Y); const float* GATE = (const float*)(F.ws + WS_GATE); const int* SEI = (const int*)(F.ws + WS_SEI);
    const float* g_fin = F.in[19]; volatile LAS int* tb = (volatile LAS int*)(F.lds + MOE_TB_OFF);
    for (int t = gw; t < NX; t += NGW) {
        const GAS u32x2* hr = (const GAS u32x2*)(H1 + (size_t)t * D) + lane_;
        f32x4 v[8];
#pragma unroll
        for (int j = 0; j < 8; ++j) { const u32x2 w = hr[64 * j]; v[j] = (f32x4){__uint_as_float(w.x << 16), __uint_as_float(w.x & 0xffff0000u), __uint_as_float(w.y << 16), __uint_as_float(w.y & 0xffff0000u)}; }
        const f32x4 gt = *(const f32x4*)(GATE + (size_t)t * 4);
        typedef int i32x4 __attribute__((ext_vector_type(4)));
        const i32x4 se = *(const i32x4*)(SEI + (size_t)t * 4);
#pragma unroll
        for (int k = 0; k < 4; ++k) { const int e = se[k] >> 16, i = se[k] & 0xffff; const size_t slot = (size_t)tb[e] * 256 + i; const float gk = gt[k];
            const GAS u32x2* yr = (const GAS u32x2*)(Y + slot * D) + lane_;
#pragma unroll
            for (int j = 0; j < 8; ++j) { const u32x2 w = yr[64 * j];
                v[j][0] += gk * __uint_as_float(w.x << 16); v[j][1] += gk * __uint_as_float(w.x & 0xffff0000u); v[j][2] += gk * __uint_as_float(w.y << 16); v[j][3] += gk * __uint_as_float(w.y & 0xffff0000u); } }
        float s = 0.f;
#pragma unroll
        for (int j = 0; j < 8; ++j) s += (v[j][0] * v[j][0] + v[j][1] * v[j][1]) + (v[j][2] * v[j][2] + v[j][3] * v[j][3]);
        float rs = 1.0f / sqrtf(wave_sum(s) * (1.0f / D) + EPS);
        GAS f32x4* orow = (GAS f32x4*)(F.out + (size_t)t * D) + lane_; const GAS f32x4* gr = (const GAS f32x4*)g_fin + lane_;
#pragma unroll
        for (int j = 0; j < 8; ++j) { const f32x4 g = gr[64 * j]; orow[64 * j] = v[j] * rs * g; }
    }
}

namespace at {
typedef float f32x16 __attribute__((ext_vector_type(16)));
typedef short s16x4 __attribute__((ext_vector_type(4)));
constexpr int NW = 8, QBLK = 32, KVBLK = 64, QB = NW * QBLK, HD = 128;
constexpr int SHM_V = KVBLK * HD * 2, SHM_K = KVBLK * HD * 2;
constexpr int ATT_LDS = 2 * SHM_V + 2 * SHM_K + NW * 64 * 4;
constexpr int LDQ = 1024, LDKV = 1024;
constexpr int NWM = 129;
constexpr float SCALE = 0.08838834764831845f, THR = 8.f;
#define KSWZ(row, colB) ((row) * 256 + ((colB) ^ (((row) & 7) << 4)))
#define SBAR() __builtin_amdgcn_sched_barrier(0)
__device__ __forceinline__ int v_st(int k, int c) { const int kk = (k & ~0xC) | ((k & 4) << 1) | ((k & 8) >> 1); return ((kk >> 3) * 4 + (c >> 5)) * 512 + ((kk & 7) * 32 + (c & 31)) * 2; }
__device__ __forceinline__ int v_rd_base(int lane) { return ((lane & 3) << 3) | (((lane >> 2) & 3) << 6) | (((lane >> 4) & 1) << 5) | (((lane >> 5) & 1) << 8); }
constexpr int v_rd_off(int d0, int ks, int half) { return d0 * 512 + ks * 4096 + half * 2048; }
__device__ __forceinline__ int crow(int r, int hi) { return (r & 3) + 8 * (r >> 2) + 4 * hi; }
__device__ __forceinline__ bf16x8 load8(const bf16_t* p) { return *reinterpret_cast<const bf16x8*>(p); }
__device__ __forceinline__ float xor1f(float v) { return __int_as_float(__builtin_amdgcn_update_dpp(0, __float_as_int(v), 0xB1, 0xF, 0xF, true)); }
__device__ __forceinline__ void mask_tile(f32x16& p0, f32x16& p1, int dq) {
    const float NEG = -__builtin_inff();
#pragma unroll
    for (int r = 0; r < 16; ++r) { const int c = (r & 3) + 8 * (r >> 2); if (dq - c < 0) p0[r] = NEG; if (dq - c - 32 < 0) p1[r] = NEG; }
}
__device__ __forceinline__ void mask_bits(f32x16& p0, f32x16& p1, unsigned long long w, int hi) {
    const unsigned long long wsft = w >> (4 * hi); const int lo = (int)(unsigned)wsft, hb = (int)(unsigned)(wsft >> 32); const int NEGB = (int)0xFF800000u;
#pragma unroll
    for (int r = 0; r < 16; ++r) { const int c = (r & 3) + 8 * (r >> 2);
        const int t0 = __builtin_amdgcn_sbfe(lo, c, 1), t1 = __builtin_amdgcn_sbfe(hb, c, 1);
        p0[r] = __int_as_float((__float_as_int(p0[r]) & t0) | (~t0 & NEGB)); p1[r] = __int_as_float((__float_as_int(p1[r]) & t1) | (~t1 & NEGB)); }
}
__device__ __forceinline__ void partialSM(f32x16& p0, f32x16& p1, float& m_reg, float& mn, float& alpha) {
    float pmax = p0[0];
#pragma unroll
    for (int r = 1; r < 16; ++r) pmax = fmaxf(pmax, p0[r]);
#pragma unroll
    for (int r = 0; r < 16; ++r) pmax = fmaxf(pmax, p1[r]);
    { auto rr = __builtin_amdgcn_permlane32_swap(__float_as_uint(pmax), __float_as_uint(pmax), false, false);
      pmax = fmaxf(__uint_as_float(rr[0]), __uint_as_float(rr[1])); }
    constexpr float C2 = 1.4426950408889634f * SCALE;
    if (__builtin_expect(__all((pmax - m_reg) * SCALE <= THR), 1)) { mn = m_reg; alpha = 1.f; }
    else { mn = fmaxf(m_reg, pmax); alpha = __builtin_amdgcn_exp2f((m_reg - mn) * C2); m_reg = mn; }
    const float mnL = -mn * C2;
#pragma unroll
    for (int r = 0; r < 16; ++r) p0[r] = fmaf(p0[r], C2, mnL);
#pragma unroll
    for (int r = 0; r < 16; ++r) p1[r] = fmaf(p1[r], C2, mnL);
#pragma unroll
    for (int r = 0; r < 16; ++r) p0[r] = __builtin_amdgcn_exp2f(p0[r]);
}
__device__ __forceinline__ void finishSM(f32x16& p0, f32x16& p1, float alpha, float& l_reg, bf16x8& pa0, bf16x8& pa1, bf16x8& pa2, bf16x8& pa3) {
#pragma unroll
    for (int r = 0; r < 16; ++r) p1[r] = __builtin_amdgcn_exp2f(p1[r]);
    float ps = 0;
#pragma unroll
    for (int r = 0; r < 16; ++r) ps += p0[r];
#pragma unroll
    for (int r = 0; r < 16; ++r) ps += p1[r];
    { auto rr = __builtin_amdgcn_permlane32_swap(__float_as_uint(ps), __float_as_uint(ps), false, false);
      ps = __uint_as_float(rr[0]) + __uint_as_float(rr[1]); }
    l_reg = l_reg * alpha + ps;
#define PK4(P, B_, OUT) do { unsigned a0 = cvt_pk_bf16(P[B_+0], P[B_+1]), a1 = cvt_pk_bf16(P[B_+2], P[B_+3]);                          \
        unsigned b0 = cvt_pk_bf16(P[B_+4], P[B_+5]), b1 = cvt_pk_bf16(P[B_+6], P[B_+7]);                                             \
        auto r0 = __builtin_amdgcn_permlane32_swap(a0, b0, false, false); auto r1 = __builtin_amdgcn_permlane32_swap(a1, b1, false, false); \
        u32x4 w = {r0[0], r1[0], r0[1], r1[1]}; OUT = *reinterpret_cast<bf16x8*>(&w); } while (0)
    PK4(p0, 0, pa0); PK4(p0, 8, pa1); PK4(p1, 0, pa2); PK4(p1, 8, pa3);
#undef PK4
}
template <int KB>
__device__ __forceinline__ void qkt(f32x16& p0, f32x16& p1, const LAS char* K_lds, int r32, int hi, const bf16x8* qr) {
    p0 = f32x16{}; p1 = f32x16{};
    const LAS char* kb[4];
#pragma unroll
    for (int dd = 0; dd < 4; ++dd) kb[dd] = K_lds + KB * SHM_K + KSWZ(r32, (dd * 16 + hi * 8) * 2);
#pragma unroll
    for (int d0 = 0; d0 < 8; ++d0) { const LAS char* a = kb[d0 & 3] + (d0 >> 2) * 128;
        bf16x8 b0 = *(const LAS bf16x8*)(a);
        bf16x8 b1 = *(const LAS bf16x8*)(a + 32 * 256);
        p0 = __builtin_amdgcn_mfma_f32_32x32x16_bf16(b0, qr[d0], p0, 0, 0, 0);
        p1 = __builtin_amdgcn_mfma_f32_32x32x16_bf16(b1, qr[d0], p1, 0, 0, 0); }
}
template <int VB>
__device__ __forceinline__ void pv_tile(f32x16* o, int vb0, bf16x8 pa0, bf16x8 pa1, bf16x8 pa2, bf16x8 pa3) {
#define TRRD(dst, off) asm volatile("ds_read_b64_tr_b16 %0, %1 offset:%2" : "=&v"(dst) : "v"(vb0), "i"(off) : "memory")
#define PV_D0(d0) do { s16x4 l0, l1, l2, l3, h0, h1, h2, h3; constexpr int b_ = VB * SHM_V + v_rd_off(d0, 0, 0); \
        TRRD(l0, b_); TRRD(h0, b_ + 2048); TRRD(l1, b_ + 4096); TRRD(h1, b_ + 6144); TRRD(l2, b_ + 8192); TRRD(h2, b_ + 10240); TRRD(l3, b_ + 12288); TRRD(h3, b_ + 14336); \
        asm volatile("s_waitcnt lgkmcnt(0)" ::: "memory"); SBAR();   \
        o[d0] = __builtin_amdgcn_mfma_f32_32x32x16_bf16(pa0, (bf16x8){l0[0], l0[1], l0[2], l0[3], h0[0], h0[1], h0[2], h0[3]}, o[d0], 0, 0, 0);   \
        o[d0] = __builtin_amdgcn_mfma_f32_32x32x16_bf16(pa1, (bf16x8){l1[0], l1[1], l1[2], l1[3], h1[0], h1[1], h1[2], h1[3]}, o[d0], 0, 0, 0);   \
        o[d0] = __builtin_amdgcn_mfma_f32_32x32x16_bf16(pa2, (bf16x8){l2[0], l2[1], l2[2], l2[3], h2[0], h2[1], h2[2], h2[3]}, o[d0], 0, 0, 0);   \
        o[d0] = __builtin_amdgcn_mfma_f32_32x32x16_bf16(pa3, (bf16x8){l3[0], l3[1], l3[2], l3[3], h3[0], h3[1], h3[2], h3[3]}, o[d0], 0, 0, 0); } while (0)
    PV_D0(0); PV_D0(1); PV_D0(2); PV_D0(3);
#undef PV_D0
#undef TRRD
}
constexpr int LDO = 3072;
struct BlockRef { unsigned q, k, v, o, m; int P0; };
struct Seam { bf16x8 qr[8]; bf16x8 st_v0, st_v1, st_k0, st_k1; };
#define VMW() asm volatile("s_waitcnt vmcnt(0)" ::: "memory")
#define VMWN(n) asm volatile("s_waitcnt vmcnt(%0)" :: "i"(n) : "memory")
#define SLOAD_H(Kp, Vp, k0) do { const bf16_t* kb_ = (Kp) + (size_t)(k0) * LDKV; const bf16_t* vb_ = (Vp) + (size_t)(k0) * LDKV;              \
                         const bf16_t* kb2_ = kb_ + 32 * LDKV; const bf16_t* vb2_ = vb_ + 32 * LDKV;                                           \
                         S.st_v0 = load8(vb_ + lo0); S.st_v1 = load8(vb2_ + lo0); S.st_k0 = load8(kb_ + lo0); S.st_k1 = load8(kb2_ + lo0); } while (0)
#define SWRITE_HK(bf) do { *(LAS bf16x8*)(K_lds + (bf) * SHM_K + kws) = S.st_k0; *(LAS bf16x8*)(K_lds + (bf) * SHM_K + kws + 32 * 256) = S.st_k1; } while (0)
#define SWRITE_HV(bf) do { *(LAS bf16x8*)(V_lds + (bf) * SHM_V + vst0) = S.st_v0; *(LAS bf16x8*)(V_lds + (bf) * SHM_V + vst0 + 8192) = S.st_v1; } while (0)
#define SWRITE_H(bf) do { SWRITE_HV(bf); SWRITE_HK(bf); } while (0)
#define QLOAD(ref) do { const bf16_t* qb_ = (const bf16_t*)(wsb + (ref).q); _Pragma("unroll") for (int d0 = 0; d0 < 8; ++d0) S.qr[d0] = load8(qb_ + qlo_off + d0 * 16); } while (0)
__device__ __forceinline__ void attn_prime(const unsigned char* wsb, const BlockRef& cur, LAS char* lds, Seam& S, int wave_) {
    const int wid = wave_, lane = fresh_lane(), tid = wid * 64 + lane, r32 = lane & 31, hi = lane >> 5;
    const int sr = tid >> 4, sc = (tid & 15) * 8, kws = KSWZ(sr, sc * 2); LAS char* K_lds = lds + 2 * SHM_V;
    const unsigned lo0 = (unsigned)(sr * LDKV + sc), qlo_off = (unsigned)((wid * QBLK + r32) * LDQ + hi * 8);
    QLOAD(cur);
    SLOAD_H((const bf16_t*)(wsb + cur.k), (const bf16_t*)(wsb + cur.v), 0); VMW(); SWRITE_HK(0);
    __syncthreads();
}
__device__ __forceinline__ void attn_block(const unsigned char* wsb, const BlockRef& cur, const BlockRef& nxt, int skv, LAS char* lds, Seam& S, int wave_) {
    const int wid = wave_, lane = fresh_lane(), tid = wid * 64 + lane, r32 = lane & 31, hi = lane >> 5;
    int j_hi = (cur.P0 + QB - 1) / KVBLK + 1; if (j_hi > skv / KVBLK) j_hi = skv / KVBLK;
    const int NT = j_hi;
    const int qlo = cur.P0 + wid * QBLK, qm = qlo + r32 - 4 * hi;
    LAS char* V_lds = lds; LAS char* K_lds = lds + 2 * SHM_V;
    LAS float* wsp = (LAS float*)(lds + 2 * SHM_V + 2 * SHM_K) + wid * 64; LAS float* li_l = wsp; LAS float* al_l = wsp + 32;
    float m_reg = -1e30f, l_reg = 0; f32x16 o[4] = {};
    const int sr = tid >> 4, sc = (tid & 15) * 8, vst0 = v_st(sr, sc), kws = KSWZ(sr, sc * 2);
    const unsigned lo0 = (unsigned)(sr * LDKV + sc), qlo_off = (unsigned)((wid * QBLK + r32) * LDQ + hi * 8);
    const int vb0 = (int)(unsigned)(uintptr_t)V_lds + v_rd_base(lane);
    const bf16_t* Kh = (const bf16_t*)(wsb + cur.k); const bf16_t* Vh = (const bf16_t*)(wsb + cur.v);
    const unsigned long long* Mb = (const unsigned long long*)(wsb + cur.m); const bool masked = cur.m != 0u; const unsigned moff = (unsigned)((wid * QBLK + r32) * NWM);
    unsigned long long mw = ~0ull;
#define MLOAD(t) do { mw = Mb[moff + (unsigned)(t)]; } while (0)
#define RESC(a) do { if (__any((a) < 1.f)) { if (hi == 0) al_l[r32] = (a); asm volatile("s_waitcnt lgkmcnt(0)" ::: "memory");              \
                     for (int d_ = 0; d_ < 4; ++d_) for (int r = 0; r < 16; ++r) o[d_][r] *= al_l[crow(r, hi)]; } } while (0)
#define KBASE(t) ((t) * KVBLK)
#define MASKT(P0_, P1_, t) do { mask_bits(P0_, P1_, mw, hi); } while (0)
    f32x16 pA0, pA1, pB0, pB1; float mnA, mnB, alA, alB; bf16x8 pa0, pa1, pa2, pa3;
    SWRITE_HV(0); SBAR();
    MLOAD(0);
    if (NT > 1) SLOAD_H(Kh, Vh, KBASE(1));
    SBAR(); qkt<0>(pA0, pA1, K_lds, r32, hi, S.qr);
    MASKT(pA0, pA1, 0); partialSM(pA0, pA1, m_reg, mnA, alA);
    if (NT > 1) { VMW(); SWRITE_H(1); }
    __syncthreads();
#define HALF_STEP(PX0, PX1, mnX, alX, PY0, PY1, alY, t, KB, VB, SB) do {                                                      \
        SBAR(); MLOAD(t); qkt<KB>(PX0, PX1, K_lds, r32, hi, S.qr);                                             \
        finishSM(PY0, PY1, alY, l_reg, pa0, pa1, pa2, pa3); SBAR();                                                           \
        if ((t) + 1 < NT) { SLOAD_H(Kh, Vh, KBASE((t) + 1)); SBAR(); }                                               \
        pv_tile<VB>(o, vb0, pa0, pa1, pa2, pa3); MASKT(PX0, PX1, (t)); partialSM(PX0, PX1, m_reg, mnX, alX);                                        \
        __syncthreads();                                                                                                      \
        if ((t) + 1 < NT) { VMW(); SWRITE_H(SB); }                                                                          \
        RESC(alX); __syncthreads(); } while (0)
    for (int t = 1; t + 1 < NT; t += 2) {
        HALF_STEP(pB0, pB1, mnB, alB, pA0, pA1, alA, t, 1, 0, 0);
        HALF_STEP(pA0, pA1, mnA, alA, pB0, pB1, alB, t + 1, 0, 1, 1);
    }
    const bool even = (NT & 1) == 0;
    if (even) { SBAR(); MLOAD(NT - 1); qkt<1>(pB0, pB1, K_lds, r32, hi, S.qr); SBAR(); }
    SLOAD_H((const bf16_t*)(wsb + nxt.k), (const bf16_t*)(wsb + nxt.v), 0); SBAR();
    QLOAD(nxt);
    SBAR();
    finishSM(pA0, pA1, alA, l_reg, pa0, pa1, pa2, pa3); SBAR();
    pv_tile<0>(o, vb0, pa0, pa1, pa2, pa3);
    if (even) { MASKT(pB0, pB1, NT - 1); partialSM(pB0, pB1, m_reg, mnB, alB); __syncthreads(); RESC(alB);
        finishSM(pB0, pB1, alB, l_reg, pa0, pa1, pa2, pa3); SBAR(); pv_tile<1>(o, vb0, pa0, pa1, pa2, pa3); }
    SBAR(); VMWN(8); SWRITE_HK(0); SBAR();
    if (hi == 0) li_l[r32] = l_reg; asm volatile("s_waitcnt lgkmcnt(0)" ::: "memory");
    float rli[16];
#pragma unroll
    for (int r = 0; r < 16; ++r) rli[r] = __builtin_amdgcn_rcpf(li_l[crow(r, hi)]);
    int hiE = hi, r32E = r32; asm volatile("" : "+v"(hiE), "+v"(r32E));
    unsigned char* Ow = (unsigned char*)(wsb + cur.o) + (unsigned)((wid * QBLK + 4 * hiE) * 2048 + r32E);
#pragma unroll
    for (int r = 0; r < 16; ++r) { const int orow = (r & 3) + 8 * (r >> 2);
#pragma unroll
        for (int d0 = 0; d0 < 4; ++d0) { const float v = o[d0][r] * (rli[r] * 16.0f);
            const float vn = xor1f(v);
            const int w = __builtin_amdgcn_cvt_pk_fp8_f32(v, vn, 0, false);
            const int w2 = __builtin_amdgcn_update_dpp(0, w, 0x4E, 0xF, 0xF, true);
            if ((r32 & 3) == 0) *(unsigned*)(Ow + orow * 2048 + d0 * 32) = ((unsigned)w & 0xffffu) | ((unsigned)w2 << 16); } }
    __syncthreads();
#undef MLOAD
#undef RESC
#undef KBASE
#undef MASKT
#undef HALF_STEP
}
#undef VMW
#undef VMWN
#undef SLOAD_H
#undef SWRITE_HK
#undef SWRITE_HV
#undef SWRITE_H
#undef QLOAD

struct CvCtx { const float* w1; const float* w2; const float* wua; const float* wub; const float* wo; unsigned char* ws; int stride; };
constexpr int CV_I1 = (D / 64) * (4096 / 32), CV_I2 = (DFF / 64) * (D / 32), CV_EXP = NE * (CV_I1 + CV_I2);
constexpr int CV_IU = (1024 / 64) * (D / 32), CV_IO = (D / 64) * (D / 32), CV_TOTAL = CV_EXP + 2 * CV_IU + CV_IO;
__device__ __forceinline__ void cv_decode(const CvCtx& c, int r, const float*& src, int& N, unsigned char*& dst) {
    if (r < NE * CV_I1) { const int e = r / CV_I1, w = r % CV_I1, kb = w >> 7, nb = w & 127;
        src = c.w1 + (size_t)e * D * 4096 + (size_t)(64 * kb) * 4096 + 32 * nb; N = 4096; dst = c.ws + WS_W1 + (size_t)e * 4096 * D + (size_t)(32 * nb) * D + 64 * kb; }
    else if (r < CV_EXP) { const int q = r - NE * CV_I1, e = q / CV_I2, w = q % CV_I2, kb = w >> 6, nb = w & 63;
        src = c.w2 + (size_t)e * DFF * D + (size_t)(64 * kb) * D + 32 * nb; N = D; dst = c.ws + WS_W2 + (size_t)e * D * DFF + (size_t)(32 * nb) * DFF + 64 * kb; }
    else { int q = r - CV_EXP; N = D;
        if (q < 2 * CV_IU) { const int second = q >= CV_IU; if (second) q -= CV_IU; const int kb = q >> 6, nb = q & 63;
            src = (second ? c.wub : c.wua) + (size_t)(64 * kb) * D + 32 * nb; dst = c.ws + WS_WUPA + (size_t)(32 * nb) * 2048 + 1024 * second + 64 * kb; }
        else { q -= 2 * CV_IU; const int kb = q >> 6, nb = q & 63; src = c.wo + (size_t)(64 * kb) * D + 32 * nb; dst = c.ws + WS_WOUT + (size_t)(32 * nb) * 2048 + 64 * kb; } }
}
__device__ __forceinline__ unsigned char* cv_load(const CvCtx& c, int r, int lane, f32x4 (&t)[8]) {
    const float* src; int N; unsigned char* dst; cv_decode(c, r, src, N, dst);
    const float* wp = src + (size_t)(lane >> 3) * N + 4 * (lane & 7);
#pragma unroll
    for (int i = 0; i < 8; ++i) t[i] = __builtin_nontemporal_load((const f32x4*)(wp + (size_t)(8 * i) * N));
    return dst;
}
__device__ __forceinline__ void cv_emit(unsigned char* dst, int lane, const f32x4 (&t)[8], LAS unsigned* scr) {
    { const int lr = lane >> 3, c4 = lane & 7;
#pragma unroll
      for (int i = 0; i < 8; ++i) { const f32x4 v = t[i] * F8_WSCALE; scr[(8 * i + lr) * 9 + c4] = cvt4_fp8(v[0], v[1], v[2], v[3]); } }
    LDS_WAIT(); asm volatile("" ::: "memory");
    const int cc = lane & 7, nq = lane >> 5, sh = (lane >> 3) & 3;
    const unsigned selA = (unsigned)sh | ((4u + (unsigned)sh) << 8);
#pragma unroll
    for (int j = 0; j < 4; ++j) { const LAS unsigned* p = scr + (8 * cc) * 9 + nq + 2 * j;
        const unsigned d0 = p[0], d1 = p[9], d2 = p[18], d3 = p[27], d4 = p[36], d5 = p[45], d6 = p[54], d7 = p[63];
        const unsigned p01 = __builtin_amdgcn_perm(d1, d0, selA), p23 = __builtin_amdgcn_perm(d3, d2, selA), p45 = __builtin_amdgcn_perm(d5, d4, selA), p67 = __builtin_amdgcn_perm(d7, d6, selA);
        u32x2 o; o.x = __builtin_amdgcn_perm(p23, p01, 0x05040100u); o.y = __builtin_amdgcn_perm(p67, p45, 0x05040100u);
        const int n = (lane >> 3) + 8 * j;
        __builtin_nontemporal_store(o, (u32x2*)(dst + (size_t)n * 2048 + 8 * cc)); }
    LDS_WAIT(); asm volatile("" ::: "memory");
}
__device__ __forceinline__ void cv_stash(const f32x4 (&t)[8], int lane, LAS unsigned* scr) {
    const int lr = lane >> 3, c4 = lane & 7;
#pragma unroll
    for (int i = 0; i < 8; ++i) { const f32x4 v = t[i] * F8_WSCALE; scr[(8 * i + lr) * 9 + c4] = cvt4_fp8(v[0], v[1], v[2], v[3]); }
}
__device__ __forceinline__ void cv_gather(const LAS unsigned* scr, int lane, int j, unsigned (&g)[8]) {
    const LAS unsigned* p = scr + (8 * (lane & 7)) * 9 + (lane >> 5) + 2 * j;
#pragma unroll
    for (int e = 0; e < 8; ++e) g[e] = p[9 * e];
}
__device__ __forceinline__ void cv_finish(unsigned char* dst, int lane, int j, const unsigned (&g)[8]) {
    const int cc = lane & 7, sh = (lane >> 3) & 3, n = (lane >> 3) + 8 * j; const unsigned selA = (unsigned)sh | ((4u + (unsigned)sh) << 8);
    const unsigned p01 = __builtin_amdgcn_perm(g[1], g[0], selA), p23 = __builtin_amdgcn_perm(g[3], g[2], selA), p45 = __builtin_amdgcn_perm(g[5], g[4], selA), p67 = __builtin_amdgcn_perm(g[7], g[6], selA);
    u32x2 o; o.x = __builtin_amdgcn_perm(p23, p01, 0x05040100u); o.y = __builtin_amdgcn_perm(p67, p45, 0x05040100u);
    __builtin_nontemporal_store(o, (u32x2*)(dst + (size_t)n * 2048 + 8 * cc));
}
template <int VB, int G>
__device__ __forceinline__ void pv_group(f32x16* o, int vb0, bf16x8 pa0, bf16x8 pa1, bf16x8 pa2, bf16x8 pa3) {
#define TRRD(dst, off) asm volatile("ds_read_b64_tr_b16 %0, %1 offset:%2" : "=&v"(dst) : "v"(vb0), "i"(off) : "memory")
    s16x4 l0, l1, l2, l3, h0, h1, h2, h3; constexpr int b_ = VB * SHM_V + v_rd_off(G, 0, 0);
    TRRD(l0, b_); TRRD(h0, b_ + 2048); TRRD(l1, b_ + 4096); TRRD(h1, b_ + 6144); TRRD(l2, b_ + 8192); TRRD(h2, b_ + 10240); TRRD(l3, b_ + 12288); TRRD(h3, b_ + 14336);
    asm volatile("s_waitcnt lgkmcnt(0)" ::: "memory"); SBAR();
    o[G] = __builtin_amdgcn_mfma_f32_32x32x16_bf16(pa0, (bf16x8){l0[0], l0[1], l0[2], l0[3], h0[0], h0[1], h0[2], h0[3]}, o[G], 0, 0, 0);
    o[G] = __builtin_amdgcn_mfma_f32_32x32x16_bf16(pa1, (bf16x8){l1[0], l1[1], l1[2], l1[3], h1[0], h1[1], h1[2], h1[3]}, o[G], 0, 0, 0);
    o[G] = __builtin_amdgcn_mfma_f32_32x32x16_bf16(pa2, (bf16x8){l2[0], l2[1], l2[2], l2[3], h2[0], h2[1], h2[2], h2[3]}, o[G], 0, 0, 0);
    o[G] = __builtin_amdgcn_mfma_f32_32x32x16_bf16(pa3, (bf16x8){l3[0], l3[1], l3[2], l3[3], h3[0], h3[1], h3[2], h3[3]}, o[G], 0, 0, 0);
    SBAR();
#undef TRRD
}
constexpr int CV_SCR0 = 139264, CV_SCRB = 2304;

struct PairRef { unsigned q, k, v, o; int P0; };
constexpr int PB_VLO = 0, PB_VHI = 32768, PB_K = 65536, PB_P = 98304, PB_SM = 135168;
__device__ __forceinline__ void attn_pair_block(const unsigned char* wsb, const PairRef& cur, int skv, LAS char* lds, int wave_, const CvCtx& cv, int& cvr) {
    const int wid = wave_, lane = fresh_lane(), r32 = lane & 31, hi = lane >> 5;
    const bool lead = wid < 4; const int w = wid & 3, tl = w * 64 + lane;
    int j_hi = (cur.P0 + 127) / KVBLK + 1; if (j_hi > skv / KVBLK) j_hi = skv / KVBLK;
    const int NT = j_hi;
    const int qlo = cur.P0 + w * QBLK, qm = qlo + r32 - 4 * hi;
    LAS char* Vlo = lds + PB_VLO; LAS char* Vhi = lds + PB_VHI; LAS char* K_lds = lds + PB_K;
    LAS char* Pb = lds + PB_P + w * 4096 + lane * 64;
    LAS float* li_l = (LAS float*)(lds + PB_SM + w * 1024); LAS float* al_l = li_l + 32; LAS int* afl = (LAS int*)(li_l + 160);
    const int sr = tl >> 4, sc = (tl & 15) * 8;
    const unsigned lo0 = (unsigned)(sr * LDKV + sc);
    const int vst0 = v_st(sr, sc), kws0 = KSWZ(sr, sc * 2);
    const int vb_lo = (int)(unsigned)(uintptr_t)Vlo + v_rd_base(lane), vb_hi = (int)(unsigned)(uintptr_t)Vhi + v_rd_base(lane);
    const bf16_t* Kh = (const bf16_t*)(wsb + cur.k); const bf16_t* Vh = (const bf16_t*)(wsb + cur.v);
#define LD4(dst, base) do { const bf16_t* b_ = (base); dst[0] = load8(b_ + lo0); dst[1] = load8(b_ + 16 * LDKV + lo0); dst[2] = load8(b_ + 32 * LDKV + lo0); dst[3] = load8(b_ + 48 * LDKV + lo0); } while (0)
#define ST4(ptr, src) do { _Pragma("unroll") for (int i_ = 0; i_ < 4; ++i_) *(LAS bf16x8*)((ptr) + 4096 * i_) = src[i_]; } while (0)
#define VMW() asm volatile("s_waitcnt vmcnt(0)" ::: "memory")
#define LGW() asm volatile("s_waitcnt lgkmcnt(0)" ::: "memory")
#define EPILOGUE(colofs) do { float rli[16];                                                                                                         \
        _Pragma("unroll") for (int r = 0; r < 16; ++r) rli[r] = __builtin_amdgcn_rcpf(li_l[crow(r, hi)]);                                            \
        int hiE = hi, r32E = r32; asm volatile("" : "+v"(hiE), "+v"(r32E));                                                                          \
        bf16_t* Ow = (bf16_t*)(wsb + cur.o) + (unsigned)((w * QBLK + 4 * hiE) * LDO + r32E) + (colofs);                                              \
        _Pragma("unroll") for (int r = 0; r < 16; ++r) { const int orow = (r & 3) + 8 * (r >> 2);                                                    \
            _Pragma("unroll") for (int d0 = 0; d0 < 4; ++d0) { const float v = o[d0][r] * rli[r]; const float vn = xor1f(v);                         \
                if ((r32 & 1) == 0) *(unsigned*)(Ow + orow * LDO + d0 * 32) = cvt_pk_bf16(v, vn); } } } while (0)
    if (lead) {
        f32x16 o[4] = {}; float m_reg = -1e30f, l_reg = 0.f;
        bf16x8 qr[8], stA[4]; f32x16 pA0, pA1, pB0, pB1; float mnA, mnB, alA, alB; bf16x8 pa0, pa1, pa2, pa3;
        { const bf16_t* qb_ = (const bf16_t*)(wsb + cur.q) + (unsigned)((w * QBLK + r32) * LDQ + hi * 8);
#pragma unroll
          for (int d0 = 0; d0 < 8; ++d0) qr[d0] = load8(qb_ + d0 * 16); }
        LD4(stA, Vh); VMW(); ST4(Vlo + vst0, stA);
        LGW(); __syncthreads();
        qkt<0>(pA0, pA1, K_lds, r32, hi, qr);
        if (KVBLK - 1 > qlo) { asm volatile("" ::: "memory"); mask_tile(pA0, pA1, qm); }
        partialSM(pA0, pA1, m_reg, mnA, alA);
        if (lane == 0) afl[0] = 0;
        LGW(); __syncthreads();
#define LFULL(s_, PAR, PX0, PX1, mnX, alX, PY0, PY1, alY) do { const int s = (s_);                                                                    \
            SBAR(); qkt<(PAR) ^ 1>(PX0, PX1, K_lds, r32, hi, qr);                                                                                    \
            finishSM(PY0, PY1, alY, l_reg, pa0, pa1, pa2, pa3); SBAR();                                                                              \
            { LAS char* pw_ = Pb + (PAR) * 16384; *(LAS bf16x8*)(pw_) = pa0; *(LAS bf16x8*)(pw_ + 16) = pa1; *(LAS bf16x8*)(pw_ + 32) = pa2; *(LAS bf16x8*)(pw_ + 48) = pa3; } \
            LD4(stA, Vh + (size_t)((s + 1) * KVBLK) * LDKV); SBAR();                                                                                 \
            pv_tile<PAR>(o, vb_lo, pa0, pa1, pa2, pa3);                                                                                              \
            { const int kb_ = (s + 1) * KVBLK; if (kb_ + KVBLK - 1 > qlo) { asm volatile("" ::: "memory"); mask_tile(PX0, PX1, qm - kb_); } }                                           \
            partialSM(PX0, PX1, m_reg, mnX, alX);                                                                                                    \
            VMW(); ST4(Vlo + ((PAR) ^ 1) * SHM_V + vst0, stA);                                                                                       \
            { const bool rs_ = __any((alX) < 1.f); const int sl_ = (s + 1) & 3; if (lane == 0) afl[sl_] = rs_ ? 1 : 0;                               \
              if (rs_) { if (hi == 0) al_l[sl_ * 32 + r32] = (alX); LGW();                                                                           \
                  _Pragma("unroll") for (int d_ = 0; d_ < 4; ++d_) _Pragma("unroll") for (int r = 0; r < 16; ++r) o[d_][r] *= al_l[sl_ * 32 + crow(r, hi)]; } } \
            LGW(); __syncthreads(); } while (0)
#define LLAST(PAR, PY0, PY1, alY) do {                                                                                                               \
            finishSM(PY0, PY1, alY, l_reg, pa0, pa1, pa2, pa3); SBAR();                                                                              \
            { LAS char* pw_ = Pb + (PAR) * 16384; *(LAS bf16x8*)(pw_) = pa0; *(LAS bf16x8*)(pw_ + 16) = pa1; *(LAS bf16x8*)(pw_ + 32) = pa2; *(LAS bf16x8*)(pw_ + 48) = pa3; } \
            pv_tile<PAR>(o, vb_lo, pa0, pa1, pa2, pa3);                                                                                              \
            LGW(); __syncthreads(); } while (0)
        int s2 = 0;
#pragma unroll 1
        for (; s2 + 2 <= NT - 1; s2 += 2) {
            LFULL(s2, 0, pB0, pB1, mnB, alB, pA0, pA1, alA);
            LFULL(s2 + 1, 1, pA0, pA1, mnA, alA, pB0, pB1, alB);
        }
        if (s2 < NT - 1) { LFULL(s2, 0, pB0, pB1, mnB, alB, pA0, pA1, alA); LLAST(1, pB0, pB1, alB); }
        else { LLAST(0, pA0, pA1, alA); }
#undef LFULL
#undef LLAST
        if (hi == 0) li_l[r32] = l_reg;
        LGW(); __syncthreads();
        EPILOGUE(0);
        __syncthreads();
    } else {
        f32x16 o[4] = {}; bf16x8 stA[4], stB[4]; bf16x8 pa0, pa1, pa2, pa3;
        f32x4 cvtA[8], cvtB[8]; unsigned char* cvpA = nullptr; unsigned char* cvpB = nullptr;
        LAS unsigned* cvscr = (LAS unsigned*)(lds + CV_SCR0 + w * CV_SCRB);
        LD4(stA, Kh); VMW(); ST4(K_lds + kws0, stA);
        LGW(); __syncthreads();
        LD4(stA, Kh + (size_t)KVBLK * LDKV); VMW(); ST4(K_lds + SHM_K + kws0, stA);
        LGW(); __syncthreads();
#define FSTEP(s_, PAR, CT, CP) do { const int s = (s_);                                            \
            unsigned char* const dst_ = (CP); const bool em_ = dst_ != nullptr && s >= 1; unsigned g_[8];                                             \
            if (dst_ != nullptr && !em_) cv_emit(dst_, lane, CT, cvscr);                                               \
            if (em_) cv_stash(CT, lane, cvscr);                                                         \
            (CP) = nullptr;                                                                                                                          \
            if (s < NT) LD4(stB, Vh + 128 + (size_t)(s * KVBLK) * LDKV);                                                                             \
            if (s + 2 < NT) LD4(stA, Kh + (size_t)((s + 2) * KVBLK) * LDKV);                                                                         \
            if (cvr < CV_TOTAL && (s & 3) != 3) { (CP) = cv_load(cv, cvr, lane, CT); cvr += cv.stride; }     \
            if (s >= 1) { const LAS char* pr_ = Pb + ((PAR) ^ 1) * 16384;                                                                            \
                pa0 = *(const LAS bf16x8*)(pr_); pa1 = *(const LAS bf16x8*)(pr_ + 16); pa2 = *(const LAS bf16x8*)(pr_ + 32); pa3 = *(const LAS bf16x8*)(pr_ + 48); \
                const int sl_ = (s - 1) & 3;                                                                                                         \
                if (afl[sl_]) { _Pragma("unroll") for (int d_ = 0; d_ < 4; ++d_) _Pragma("unroll") for (int r = 0; r < 16; ++r) o[d_][r] *= al_l[sl_ * 32 + crow(r, hi)]; } \
                pv_group<(PAR) ^ 1, 0>(o, vb_hi, pa0, pa1, pa2, pa3);                                                                                \
                if (em_) cv_gather(cvscr, lane, 0, g_);                                                 \
                pv_group<(PAR) ^ 1, 1>(o, vb_hi, pa0, pa1, pa2, pa3);                                                                                \
                if (em_) { cv_finish(dst_, lane, 0, g_); cv_gather(cvscr, lane, 1, g_); }                                                            \
                pv_group<(PAR) ^ 1, 2>(o, vb_hi, pa0, pa1, pa2, pa3);                                                                                \
                if (em_) { cv_finish(dst_, lane, 1, g_); cv_gather(cvscr, lane, 2, g_); }                                                            \
                pv_group<(PAR) ^ 1, 3>(o, vb_hi, pa0, pa1, pa2, pa3);                                                                                \
                if (em_) { cv_finish(dst_, lane, 2, g_); cv_gather(cvscr, lane, 3, g_); } }                                                          \
            if (s < NT) ST4(Vhi + (PAR) * SHM_V + vst0, stB);                                                                                        \
            if (s + 2 < NT) ST4(K_lds + (PAR) * SHM_K + kws0, stA);                                                                                  \
            LGW(); if (em_) cv_finish(dst_, lane, 3, g_);                                                                                            \
            __syncthreads(); } while (0)
#pragma unroll 1
        for (int s2 = 0; s2 <= NT; s2 += 2) {
            FSTEP(s2, 0, cvtA, cvpA);
            if (s2 + 1 <= NT) FSTEP(s2 + 1, 1, cvtB, cvpB);
        }
#undef FSTEP
        if (cvpA) cv_emit(cvpA, lane, cvtA, cvscr);
        if (cvpB) cv_emit(cvpB, lane, cvtB, cvscr);
        EPILOGUE(128);
        __syncthreads();
    }
#undef EPILOGUE
#undef LD4
#undef ST4
#undef VMW
#undef LGW
}
}

__device__ __forceinline__ at::BlockRef attn_ref(int bv, int qb) {
    const int b = bv / 24, vh = bv - b * 24; const unsigned row = (unsigned)(b * SEQ + qb * 256);
    at::BlockRef r; r.P0 = NMETA + qb * 256;
    if (vh < 8) { const unsigned h = (unsigned)vh;
        r.q = (unsigned)WS_QA + (row * 1024u + h * 128u) * 2u; r.k = (unsigned)WS_KA + ((unsigned)(b * TP) * 1024u + h * 128u) * 2u; r.v = (unsigned)WS_VA + ((unsigned)(b * TP) * 1024u + h * 128u) * 2u;
        r.o = (unsigned)WS_OA8 + row * 2048u + h * 128u; r.m = (unsigned)WS_MASK + row * (unsigned)at::NWM * 8u; }
    else { const unsigned j = (unsigned)(vh - 8), h = j >> 2, br = (j >> 1) & 1u, hf = j & 1u;
        r.q = (unsigned)WS_QB + (row * 1024u + h * 256u + br * 128u) * 2u; r.k = (unsigned)WS_KB + ((unsigned)(b * TP) * 1024u + h * 256u + br * 128u) * 2u; r.v = (unsigned)WS_VB + ((unsigned)(b * TP) * 1024u + h * 256u + hf * 128u) * 2u;
        r.o = (unsigned)WS_OALL + (row * (unsigned)at::LDO + 1024u + h * 512u + br * 256u + hf * 128u) * 2u; r.m = 0u; }
    return r;
}
__device__ __forceinline__ void attn_item(int L, int& bv, int& qb0, int& qb1) { const int xcd = L & 7, slot = (L >> 3) & 31, rnd = L >> 8; bv = rnd * 16 + xcd * 2 + (slot >> 4); const int pair = slot & 15; qb0 = pair; qb1 = 31 - pair; }
__device__ __forceinline__ void attn_phase(Frame& F) {
    constexpr int TOTAL = 768; const int stride = F.G;
    LAS char* lds = (LAS char*)(F.lds + RING_OFF);
    const unsigned char* wsb = F.ws;
    const at::CvCtx cv{F.in[15], F.in[17], F.in[9], F.in[10], F.in[11], F.ws, 4 * F.G};
    int cvr = (int)blockIdx.x * 4 + (F.wave & 3);
    for (int L = (int)blockIdx.x; L < TOTAL; L += stride) {
        const int xcd = L & 7, slot = (L >> 3) & 31, rnd = L >> 8; const int bv = rnd * 16 + xcd * 2 + (slot >> 4), pr = slot & 15;
        const int b = bv / 24, vh = bv - b * 24;
        if (vh < 8) {
            at::BlockRef cur = attn_ref(bv, pr); const at::BlockRef nxt = attn_ref(bv, 31 - pr);
            at::Seam S;
            at::attn_prime(wsb, cur, lds, S, F.wave);
            at::attn_block(wsb, cur, nxt, TP, lds, S, F.wave);
            at::attn_block(wsb, nxt, nxt, TP, lds, S, F.wave);
            __syncthreads();
        } else {
            const unsigned j = (unsigned)(vh - 8), h = j >> 2, br = (j >> 1) & 1u, hf = j & 1u; const int p = 16 * (int)hf + pr;
#pragma unroll 1
            for (int pass = 0; pass < 2; ++pass) {
                const int qb = pass ? 63 - p : p; const unsigned row = (unsigned)(b * SEQ + qb * 128);
                at::PairRef r; r.P0 = NMETA + qb * 128;
                r.q = (unsigned)WS_QB + (row * 1024u + h * 256u + br * 128u) * 2u; r.k = (unsigned)WS_KB + ((unsigned)(b * TP) * 1024u + h * 256u + br * 128u) * 2u;
                r.v = (unsigned)WS_VB + ((unsigned)(b * TP) * 1024u + h * 256u) * 2u; r.o = (unsigned)WS_OALL + (row * (unsigned)at::LDO + 1024u + h * 512u + br * 256u) * 2u;
                at::attn_pair_block(wsb, r, TP, lds, F.wave, cv, cvr);
            }
        }
    }
    {
        LAS int* cvsh = (LAS int*)(lds + at::CV_SCR0); const int lane = fresh_lane();
        __syncthreads();
        if (F.wave >= 4 && lane == 0) cvsh[F.wave - 4] = cvr;
        __syncthreads();
        int r = cvsh[F.wave & 3] + (F.wave >> 2) * cv.stride;
        __syncthreads();
        LAS unsigned* scr = (LAS unsigned*)(F.lds + RING_OFF + F.wave * 16384);
        for (; r < at::CV_TOTAL; r += 2 * cv.stride) { f32x4 t[8]; unsigned char* d = at::cv_load(cv, r, lane, t); at::cv_emit(d, lane, t, scr); }
    }
}
__device__ __forceinline__ void diff_phase(Frame& F) {
    const int gw = F.vcu * NWAVES + F.wave, NGW = F.G * NWAVES, lane = fresh_lane();
    const float* lq1 = F.in[4]; const float* lk1 = F.in[5]; const float* lq2 = F.in[6]; const float* lk2 = F.in[7]; const float* sg = F.in[8];
    const float s1 = wave_sum(lq1[lane] * lk1[lane] + lq1[lane + 64] * lk1[lane + 64]), s2 = wave_sum(lq2[lane] * lk2[lane] + lq2[lane + 64] * lk2[lane + 64]);
    const float lam = __expf(s1) - __expf(s2) + 0.2f;
    const f32x4 g4 = *(const f32x4*)(sg + 4 * lane);
    const bf16_t* OBR = (const bf16_t*)(F.ws + WS_OALL) + 1024; unsigned char* OB8 = F.ws + WS_OA8 + 1024;
    for (int r = gw; r < NX; r += NGW) {
#pragma unroll
        for (int h = 0; h < 4; ++h) {
            const u32x2 a = *(const u32x2*)(OBR + (size_t)r * at::LDO + h * 512 + 4 * lane), c = *(const u32x2*)(OBR + (size_t)r * at::LDO + h * 512 + 256 + 4 * lane);
            f32x4 d;
            d[0] = __uint_as_float(a.x << 16) - lam * __uint_as_float(c.x << 16); d[1] = __uint_as_float(a.x & 0xffff0000u) - lam * __uint_as_float(c.x & 0xffff0000u);
            d[2] = __uint_as_float(a.y << 16) - lam * __uint_as_float(c.y << 16); d[3] = __uint_as_float(a.y & 0xffff0000u) - lam * __uint_as_float(c.y & 0xffff0000u);
            const float ss = wave_sum((d[0] * d[0] + d[1] * d[1]) + (d[2] * d[2] + d[3] * d[3]));
            const float rs = 0.8f / sqrtf(ss * (1.0f / 256.0f) + EPS);
            *(unsigned*)(OB8 + (size_t)r * D + h * 256 + 4 * lane) = cvt4_fp8(d[0] * rs * g4[0], d[1] * rs * g4[1], d[2] * rs * g4[2], d[3] * rs * g4[3]);
        }
    }
}
typedef float f32x16i __attribute__((ext_vector_type(16)));
constexpr int IDX_ROWB = 144, IDX_CHUNK = 128, IDX_BUF = IDX_CHUNK * IDX_ROWB;
__device__ __forceinline__ void idx_phase(Frame& F) {
    const int lane = fresh_lane(), wave = F.wave, tid = wave * 64 + lane, n = lane & 31, hh = lane >> 5;
    const bf16_t* QI = (const bf16_t*)(F.ws + WS_QI); const bf16_t* KI = (const bf16_t*)(F.ws + WS_KI); const float* WI = (const float*)(F.ws + WS_WI); float* SC = (float*)(F.ws + WS_SC);
    LAS unsigned char* buf = F.lds + RING_OFF;
    for (int L = (int)blockIdx.x; L < 512; L += F.G) {
        const int b = (L >> 7) & 1, j = L & 127, hu = (L >> 8) ? 255 - j : j;
        const int P = NMETA + hu * 32;
        const int r0 = b * SEQ + hu * 32 + wave * 4;
        const int qq = (lane >> 2) & 1, hA = (lane & 3) + 4 * (n >> 3);
        bf16x8 afr[2][4]; float wv[2][16];
#pragma unroll
        for (int p = 0; p < 2; ++p) {
            const bf16_t* qp = QI + (size_t)(r0 + 2 * p + qq) * 1024 + hA * 64 + 8 * hh;
#pragma unroll
            for (int s = 0; s < 4; ++s) afr[p][s] = *(const bf16x8*)(qp + 16 * s);
            const float* wp = WI + (size_t)(r0 + 2 * p + hh) * 16;
#pragma unroll
            for (int h4 = 0; h4 < 4; ++h4) { const f32x4 t = *(const f32x4*)(wp + 4 * h4); wv[p][4 * h4] = t[0]; wv[p][4 * h4 + 1] = t[1]; wv[p][4 * h4 + 2] = t[2]; wv[p][4 * h4 + 3] = t[3]; }
        }
        const int lastpos = P + 31, nch = lastpos / IDX_CHUNK + 1;
        const bf16_t* kbase = KI + (size_t)b * TP * 64;
        const int k0i = tid >> 3, c16 = tid & 7;
        u32x4 st0, st1;
        __syncthreads();
        st0 = *(const u32x4*)(kbase + (size_t)(k0i) * 64 + c16 * 8); st1 = *(const u32x4*)(kbase + (size_t)(k0i + 64) * 64 + c16 * 8);
        *(LAS u32x4*)(buf + k0i * IDX_ROWB + c16 * 16) = st0; *(LAS u32x4*)(buf + (k0i + 64) * IDX_ROWB + c16 * 16) = st1;
        __syncthreads();
        for (int c = 0; c < nch; ++c) {
            const bool more = c + 1 < nch;
            if (more) { const bf16_t* kp = kbase + (size_t)((c + 1) * IDX_CHUNK) * 64;
                st0 = *(const u32x4*)(kp + (size_t)(k0i) * 64 + c16 * 8); st1 = *(const u32x4*)(kp + (size_t)(k0i + 64) * 64 + c16 * 8); }
            LAS unsigned char* cb = buf + (c & 1) * IDX_BUF;
#pragma unroll
            for (int sub = 0; sub < 4; ++sub) {
                const int key0 = c * IDX_CHUNK + sub * 32;
                if (key0 <= lastpos) {
                    bf16x8 bfr[4];
#pragma unroll
                    for (int s = 0; s < 4; ++s) bfr[s] = *(const LAS bf16x8*)(cb + (sub * 32 + n) * IDX_ROWB + (16 * s + 8 * hh) * 2);
#pragma unroll
                    for (int p = 0; p < 2; ++p) {
                        f32x16i acc = {};
#pragma unroll
                        for (int s = 0; s < 4; ++s) acc = __builtin_amdgcn_mfma_f32_32x32x16_bf16(afr[p][s], bfr[s], acc, 0, 0, 0);
                        float sc = 0.f;
#pragma unroll
                        for (int h = 0; h < 16; ++h) sc = fmaf(wv[p][h], fmaxf(acc[h], 0.f), sc);
                        SC[(size_t)(r0 + 2 * p + hh) * TP + key0 + n] = sc;
                    }
                }
            }
            if (more) { LAS unsigned char* nb = buf + ((c + 1) & 1) * IDX_BUF;
                *(LAS u32x4*)(nb + k0i * IDX_ROWB + c16 * 16) = st0; *(LAS u32x4*)(nb + (k0i + 64) * IDX_ROWB + c16 * 16) = st1; }
            __syncthreads();
        }
    }
}
__device__ __forceinline__ unsigned f2key(float f) { const unsigned u = __float_as_uint(f); return (u & 0x80000000u) ? ~u : (u | 0x80000000u); }
__device__ __forceinline__ void topk_phase(Frame& F) {
    const int gw = F.vcu * NWAVES + F.wave, NGW = F.G * NWAVES, lane = fresh_lane();
    const float* SC = (const float*)(F.ws + WS_SC); unsigned long long* MASK = (unsigned long long*)(F.ws + WS_MASK);
    LAS unsigned* cbuf = (LAS unsigned*)(F.lds + RING_OFF + F.wave * 8192);
    for (int row = gw; row < NX; row += NGW) {
        const int q = row & (SEQ - 1), n = NMETA + q + 1;
        const float* sr = SC + (size_t)row * TP;
        unsigned key[128]; unsigned key128;
        const int dln = 128 * lane - n;
        {
            const f32x4* lp = (const f32x4*)(sr + 128 * lane);
            const bool live = dln < 0;
#pragma unroll
            for (int j4 = 0; j4 < 32; ++j4) { f32x4 v = {0.f, 0.f, 0.f, 0.f}; if (live) v = lp[j4];
#pragma unroll
                for (int e = 0; e < 4; ++e) { const int j = 4 * j4 + e; const unsigned u = __float_as_uint(v[e]); const unsigned sgn = (unsigned)((int)u >> 31);
                    key[j] = (u ^ (sgn | 0x80000000u)) & (unsigned)((dln + j) >> 31); }
                if ((j4 & 7) == 7) __builtin_amdgcn_sched_barrier(0); }
            const unsigned u = __float_as_uint(sr[8192 + (lane & 15)]); const unsigned sgn = (unsigned)((int)u >> 31);
            key128 = (lane < 16 && 8192 + lane < n) ? (u ^ (sgn | 0x80000000u)) : 0u;
        }
        unsigned thr = 1u; bool exact = true;
        if (n > 256) {
            exact = false; bool done = false; unsigned prefix = 0u;
            unsigned ts = 1u;
            if (n > 1536) {
                ts = 0u;
                for (int bit = 31; bit >= 14; --bit) {
                    const unsigned cand = ts | (1u << bit); int cl = 0;
#pragma unroll
                    for (int i = 0; i < 8; ++i) cl += __popcll(__ballot(key[16 * i] >= cand));
                    if (cl >= 34) ts = cand;
                }
            }
            LAS unsigned* dump = cbuf + 24 * 64 + lane; int ctot = 0;
#pragma unroll
            for (int j = 0; j < 129; ++j) { const unsigned kv = j < 128 ? key[j] : key128; const bool p = kv >= ts;
                const unsigned long long m = __ballot(p);
                const int pos = ctot + (int)__builtin_amdgcn_mbcnt_hi((unsigned)(m >> 32), __builtin_amdgcn_mbcnt_lo((unsigned)m, 0u));
                LAS unsigned* a = (p && pos < 24 * 64) ? cbuf + pos : dump; *a = kv; ctot += __popcll(m);
                if ((j & 7) == 7) __builtin_amdgcn_sched_barrier(0); }
            LDS_WAIT(); asm volatile("" ::: "memory");
            if (ctot >= 256 && ctot <= 24 * 64) {
                unsigned cd[24]; const int nr = (ctot + 63) >> 6;
#pragma unroll
                for (int r = 0; r < 24; ++r) { const unsigned v = cbuf[64 * r + lane]; cd[r] = (64 * r + lane < ctot) ? v : 0u; }
                for (int bit = 31; bit >= 0; --bit) {
                    const unsigned cand = prefix | (1u << bit); int cnt = 0;
#pragma unroll
                    for (int r = 0; r < 24; ++r) if (r < nr) cnt += __popcll(__ballot(cd[r] >= cand));
                    if (cnt >= 256) { prefix = cand; if (cnt == 256) { exact = true; break; } }
                }
                done = true;
            }
            LDS_WAIT(); asm volatile("" ::: "memory");
            if (!done) {
                prefix = 0u; exact = false;
                for (int bit = 31; bit >= 0; --bit) {
                    const unsigned cand = prefix | (1u << bit); int cl = (key128 >= cand) ? 1 : 0;
#pragma unroll
                    for (int j = 0; j < 128; ++j) cl += (key[j] >= cand) ? 1 : 0;
#pragma unroll
                    for (int o = 1; o < 64; o <<= 1) cl += __shfl_xor(cl, o);
                    const int cnt = __builtin_amdgcn_readfirstlane(cl);
                    if (cnt >= 256) { prefix = cand; if (cnt == 256) { exact = true; break; } }
                }
            }
            thr = prefix;
        }
        unsigned w0 = 0u, w1 = 0u, w2 = 0u, w3 = 0u; unsigned long long wx;
        if (__builtin_expect(exact, 1)) {
#pragma unroll
            for (int j = 31; j >= 0; --j) { w0 = w0 + w0 + ((key[j] >= thr) ? 1u : 0u); w1 = w1 + w1 + ((key[32 + j] >= thr) ? 1u : 0u); w2 = w2 + w2 + ((key[64 + j] >= thr) ? 1u : 0u); w3 = w3 + w3 + ((key[96 + j] >= thr) ? 1u : 0u); }
            wx = __ballot(key128 >= thr);
        } else {
            unsigned thr2 = thr; asm volatile("" : "+v"(thr2));
            int cg = (key128 > thr2) ? 1 : 0, ce = 0;
#pragma unroll
            for (int j = 0; j < 128; ++j) { cg += (key[j] > thr2) ? 1 : 0; ce += (key[j] == thr2) ? 1 : 0; }
            int cgt = cg;
#pragma unroll
            for (int o = 1; o < 64; o <<= 1) cgt += __shfl_xor(cgt, o);
            const int need = 256 - __builtin_amdgcn_readfirstlane(cgt);
            int incl = ce;
#pragma unroll
            for (int o = 1; o < 64; o <<= 1) { const int t = __shfl_up(incl, o); if (lane >= o) incl += t; }
            const int before = incl - ce; const int etot = __shfl(incl, 63);
            int allow = need - before; allow = allow < 0 ? 0 : allow;
            int seen = 0;
#define TK_BIT(W, J) { const unsigned kv_ = key[J]; const bool eq_ = kv_ == thr; const bool tk_ = (kv_ > thr) || (eq_ && seen < allow); seen += eq_ ? 1 : 0; W |= tk_ ? (1u << ((J) & 31)) : 0u; }
#pragma unroll
            for (int j = 0; j < 32; ++j) TK_BIT(w0, j)
#pragma unroll
            for (int j = 32; j < 64; ++j) TK_BIT(w1, j)
#pragma unroll
            for (int j = 64; j < 96; ++j) TK_BIT(w2, j)
#pragma unroll
            for (int j = 96; j < 128; ++j) TK_BIT(w3, j)
#undef TK_BIT
            const bool eqx = key128 == thr; const unsigned long long mx = __ballot(eqx);
            const int rankx = etot + (int)__builtin_amdgcn_mbcnt_hi((unsigned)(mx >> 32), __builtin_amdgcn_mbcnt_lo((unsigned)mx, 0u));
            wx = __ballot((key128 > thr) || (eqx && rankx < need));
        }
        unsigned long long* mr = MASK + (size_t)row * 129;
        *(u32x4*)(mr + 2 * lane) = (u32x4){w0, w1, w2, w3};
        if (lane == 0) mr[128] = wx & 0xffffull;
    }
}

struct Args { const float* in[20]; float* out; unsigned char* ws; int ph_lo, ph_hi, li, pad; };
constexpr int NPHASE = 13;

__global__ void __launch_bounds__(NTHR, 2) mega(Args args) {
    extern __shared__ __attribute__((aligned(16))) unsigned char lds_raw[];
    Frame F;
    F.lds = (LAS unsigned char*)lds_raw;
    F.MISC = (volatile LAS unsigned*)(F.lds + MISC_OFF);
    F.wave = __builtin_amdgcn_readfirstlane(threadIdx.x >> 6);
    F.G = gridDim.x; { const int bx = blockIdx.x; F.vcu = (F.G % 8 == 0) ? (bx % 8) * (F.G / 8) + bx / 8 : bx; }
    F.ws = args.ws; F.ctl = (unsigned*)(args.ws + WS_CTL); F.out = args.out;
#pragma unroll
    for (int i = 0; i < 20; ++i) F.in[i] = args.in[i];
    for (int u = (int)threadIdx.x; u < (LDS_BYTES - LDSCTL_OFF) / 4; u += NTHR) ((LAS unsigned*)(F.lds + LDSCTL_OFF))[u] = 0u;
    __syncthreads();
    XcdBarrier bar = xcd_barrier_post(F.ctl + CW_BAR + args.li * XCD_BAR_WORDS, F.MISC + 8); bar.wave = F.wave;
    const int lo = args.ph_lo, hi = args.ph_hi;
    unsigned char* ws = F.ws;
    volatile LAS int* tb = (volatile LAS int*)(F.lds + MOE_TB_OFF); volatile LAS int* cnt = (volatile LAS int*)(F.lds + MOE_CNT_OFF);
#define IN(k) (lo <= (k) && (k) < hi)
#define SEAM(k) do { if (IN(k) && hi > (k) + 1) xcd_barrier(bar); } while (0)
    if (IN(0)) { p0_prologue(F); SEAM(0); }
    if (IN(1)) {
        {
            WindowOrder S; S.init(MROWS / 256, GATE_TILE0 + 1, 0, F.G, (int)blockIdx.x);
            struct Remap { WindowOrder w; __device__ bool next(int i, Unit& u) const { if (!w.next(i, u)) return false; if (u.pn == GATE_TILE0) u.pn = 44; return true; } __device__ __forceinline__ int rows(const Unit&) const { return 256; } } R{S};
            DenseAB P{(const char*)(ws + WS_HN), (const char*)(ws + WS_WIN), D, D};
            EpiInProj E{ws, 1.0f};
            gemm_phase(F.lds + RING_OFF, 2 * D, R, P, E, F.wave);
        }
        {
            struct GateOrder { DenseOrder d; int c, G, nb8;
                __device__ bool next(int i, Unit& u) const {
                    int L;
                    if (G != 256) { L = i * G + c; if (L >= 1024) return false; }
                    else if (i < 3) L = i * 256 + c;
                    else if (i == 3 && c >= nb8) L = 768 + (c - nb8);
                    else if (i == 4 && c >= nb8 && c < 2 * nb8) L = 768 + (256 - nb8) + (c - nb8);
                    else return false;
                    DenseOrder t = d; t.c = L % G; if (!t.next(L / G, u)) return false; u.pn += GATE_TILE0; return true; }
                __device__ __forceinline__ int rows(const Unit&) const { return 256; } };
            GateOrder S; S.d.init(NX / 256, 16, F.G, 0); S.c = (int)blockIdx.x; S.G = F.G; S.nb8 = ((MROWS / 256) * (GATE_TILE0 + 1)) % 256;
            DenseAB8 P{(const char*)(ws + WS_HN8), (const char*)(ws + WS_WIN8), D, D, GATE_TILE0};
            EpiInProj E{ws, F8_WINV};
            gemm_phase<true>(F.lds + RING_OFF, D, S, P, E, F.wave);
        }
        SEAM(1);
    }
    if (IN(2)) { idx_phase(F); SEAM(2); }
    if (IN(3)) { topk_phase(F); SEAM(3); }
    if (IN(4)) { attn_phase(F); SEAM(4); }
    if (IN(5)) { diff_phase(F); SEAM(5); }
    if (IN(6)) {
        DenseOrder S; S.init(NX / 256, D / 256, F.G, (int)blockIdx.x);
        DenseAB8 P{(const char*)(ws + WS_OA8), (const char*)(ws + WS_WUPA), D, D, 0};
        EpiUp E{(const bf16_t*)(ws + WS_GA), (const bf16_t*)(ws + WS_GB), ws + WS_MG, 1.0f / OA8_SCALE, F8_WINV};
        gemm_phase<true>(F.lds + RING_OFF, D, S, P, E, F.wave);
        SEAM(6);
    }
    if (IN(8)) {
        DenseOrder S; S.init(NX / 256, D / 256, F.G, (int)blockIdx.x);
        DenseAB8 P{(const char*)(ws + WS_MG), (const char*)(ws + WS_WOUT), D, D, 0};
        EpiOut E{F.in[0], (bf16_t*)(ws + WS_H1), F8_WINV};
        gemm_phase<true>(F.lds + RING_OFF, D, S, P, E, F.wave);
        SEAM(8);
    }
    if (IN(9)) { router_phase(F); SEAM(9); }
    if (IN(10)) {
        moe_tables(F);
        MoeOrder S{F.G, (int)blockIdx.x, 4096 / 256, tb};
        MoeAB1 P{(const char*)(ws + WS_HB), (const char*)(ws + WS_W1), (const int*)(ws + WS_LIST), tb, cnt};
        EpiMoe1 E{F.in[16], ws + WS_G};
        gemm_phase<true>(F.lds + RING_OFF, D, S, P, E, F.wave);
        SEAM(10);
    }
    if (IN(11)) {
        moe_tables(F);
        MoeOrder S{F.G, (int)blockIdx.x, D / 256, tb};
        MoeAB2 P{(const char*)(ws + WS_G), (const char*)(ws + WS_W2)};
        EpiMoe2 E{F.in[18], (bf16_t*)(ws + WS_Y)};
        gemm_phase<true>(F.lds + RING_OFF, DFF, S, P, E, F.wave);
        SEAM(11);
    }
    if (IN(12)) { moe_tables(F); final_phase(F); }
#undef IN
#undef SEAM
}

}
#ifndef MK_PER_PHASE
#define MK_PER_PHASE 0
#endif
extern "C" void kernel_launch(void* const* d_in, const int* in_sizes, int n_in, void* d_out, int out_size, void* d_ws, size_t ws_size, hipStream_t stream) {
    static int grid = 0;
    if (grid == 0) {
        if (n_in != 20 || out_size != mk::NX * mk::D || ws_size < mk::WS_END2) { fprintf(stderr, "kernel_launch: unexpected problem shape or workspace (n_in %d, out %d, ws %zu < %zu)\n", n_in, out_size, ws_size, (size_t)mk::WS_END2); grid = -1; return; }
        int dev = 0, cus = 0;
        if (hipGetDevice(&dev) != hipSuccess || hipDeviceGetAttribute(&cus, hipDeviceAttributeMultiprocessorCount, dev) != hipSuccess) { grid = -1; return; }
        if (hipFuncSetAttribute((const void*)mk::mega, hipFuncAttributeMaxDynamicSharedMemorySize, mk::LDS_BYTES) != hipSuccess) { fprintf(stderr, "hipFuncSetAttribute failed\n"); grid = -1; return; }
        int per_cu = 0; (void)hipOccupancyMaxActiveBlocksPerMultiprocessor(&per_cu, (const void*)mk::mega, mk::NTHR, mk::LDS_BYTES); (void)hipGetLastError();
        grid = cus;
    }
    if (grid < 0) return;
    (void)hipMemsetAsync((char*)d_ws + mk::WS_CTL, 0, mk::CTL_BYTES, stream);
    mk::Args a{};
    for (int i = 0; i < 20; ++i) a.in[i] = (const float*)d_in[i];
    a.out = (float*)d_out; a.ws = (unsigned char*)d_ws;
#if MK_PER_PHASE
    for (int ph = 0; ph < mk::NPHASE; ++ph) { a.ph_lo = ph; a.ph_hi = ph + 1; a.li = ph; hipLaunchKernelGGL(mk::mega, dim3(grid), dim3(mk::NTHR), mk::LDS_BYTES, stream, a); }
#else
    a.ph_lo = 0; a.ph_hi = mk::NPHASE; a.li = 0;
    hipLaunchKernelGGL(mk::mega, dim3(grid), dim3(mk::NTHR), mk::LDS_BYTES, stream, a);
#endif
}
```
